# Optimizing an MI355X kernel written in HIP

```python
import jax, jax.numpy as jnp
from jax import lax
import numpy as np

D_MODEL = 1024
BATCH = 16
SEQ = 4096
DEPTH = 2
DEC_BATCH = 8
DEC_SEQ = 64
PAST_LEN = 2048

CHUNK = 64
D_MIX = D_MODEL
D_CONV = D_MIX // 2
D_RWKV = D_MIX - D_CONV
HEAD_DIM = 64
N_HEADS = D_RWKV // HEAD_DIM
CONV_WIDTH = 31
CONV_BUF = min(CONV_WIDTH - 1, PAST_LEN)
LORA_W = 64
LORA_A = 64
LORA_G = 128
D_SHIFT = 3 * D_RWKV + LORA_W + LORA_A + LORA_G
D_IN = 2 * D_CONV + D_SHIFT
D_FF = -(-8 * D_MODEL // (3 * 256)) * 256
RWKV_SPLIT = (D_RWKV, 2 * D_RWKV, 3 * D_RWKV, 3 * D_RWKV + LORA_W, 3 * D_RWKV + LORA_W + LORA_A)
RMS_EPS = 1e-6
LN_EPS = 1e-5
GN_EPS = 64e-5
L2_EPS = 1e-12

kernel_name = 'hymba_conformer_rwkv7_stream_step'


def _rms_norm(x, g):
    xf = x.astype(jnp.float32)
    y = xf * lax.rsqrt(jnp.mean(xf * xf, axis=-1, keepdims=True) + RMS_EPS)
    return (y * g.astype(jnp.float32)).astype(x.dtype)


def _layer_norm(x, g, b):
    xf = x.astype(jnp.float32)
    m = jnp.mean(xf, axis=-1, keepdims=True)
    v = jnp.mean(jnp.square(xf - m), axis=-1, keepdims=True)
    y = (xf - m) * lax.rsqrt(v + LN_EPS) * g.astype(jnp.float32) + b.astype(jnp.float32)
    return y.astype(x.dtype)


def _conv_mix(u, conv_buf, conv_dw, conv_b, ln_g, ln_b):
    glu = u[..., :D_CONV] * jax.nn.sigmoid(u[..., D_CONV:])
    full = jnp.concatenate([conv_buf.astype(glu.dtype), glu], axis=1)
    y = lax.conv_general_dilated(full, conv_dw[:, None, :].astype(full.dtype), window_strides=(1,),
                                 padding='VALID', dimension_numbers=('NWC', 'WIO', 'NWC'),
                                 feature_group_count=D_CONV) + conv_b
    y = _layer_norm(y, ln_g, ln_b)
    return y * jax.nn.sigmoid(y), full[:, -CONV_BUF:]


def _wkv_step(S, inp):
    r, w, k, v, kk, kka = inp
    sa = jnp.einsum('bhvk,bhk->bhv', S, -kk)
    S = S * w[:, :, None, :] + sa[..., None] * kka[:, :, None, :] + v[..., None] * k[:, :, None, :]
    return S, jnp.einsum('bhvk,bhk->bhv', S, r)


def _rwkv_mix(z, shift_prev, wkv0, mu_shift, w0, w2, a0, a2, g2, k_k, k_a, r_k, lnx_g, lnx_b):
    B, T, _ = z.shape
    f32 = jnp.float32
    z_prev = jnp.concatenate([shift_prev[:, None, :].astype(z.dtype), z[:, :-1]], axis=1)
    zm = z + (z_prev - z) * mu_shift
    zr, zk, zv, zw, za, zg = jnp.split(zm, RWKV_SPLIT, axis=-1)
    heads = lambda t: t.astype(f32).reshape(B, T, N_HEADS, HEAD_DIM)
    w_log = -jax.nn.softplus(-(w0 + jnp.tanh(zw) @ w2).astype(f32)) - 0.5
    decay = heads(jnp.exp(-jnp.exp(w_log)))
    a = heads(jax.nn.sigmoid((a0 + za @ a2).astype(f32)))
    g = jax.nn.sigmoid(zg) @ g2
    r, k, v = heads(zr), heads(zk), heads(zv)
    kk = k * k_k.astype(f32).reshape(N_HEADS, HEAD_DIM)
    kk = kk * lax.rsqrt(jnp.sum(kk * kk, axis=-1, keepdims=True) + L2_EPS)
    k = k * (1.0 + (a - 1.0) * k_a.astype(f32).reshape(N_HEADS, HEAD_DIM))
    tm = lambda t: jnp.moveaxis(t, 1, 0)
    S_fin, ys = lax.scan(_wkv_step, wkv0.astype(f32), (tm(r), tm(decay), tm(k), tm(v), tm(kk), tm(kk * a)))
    y = jnp.moveaxis(ys, 0, 1)
    m = jnp.mean(y, axis=-1, keepdims=True)
    var = jnp.mean(jnp.square(y - m), axis=-1, keepdims=True)
    y = ((y - m) * lax.rsqrt(var + GN_EPS)).reshape(B, T, D_RWKV) * lnx_g + lnx_b
    bonus = (jnp.sum(r * k * r_k.astype(f32), axis=-1, keepdims=True) * v).reshape(B, T, D_RWKV)
    out = ((y + bonus) * g.astype(f32)).astype(z.dtype)
    return out, z[:, -1], S_fin.astype(wkv0.dtype)


def _layer(x, c, conv_buf, shift_prev, wkv, w_mod, b_mod, g_mix_pre, g_mix_post, g_ffn_pre, g_ffn_post,
           w_in, conv_dw, conv_b, conv_ln_g, conv_ln_b, mu_shift, w0, w2, a0, a2, g2, k_k, k_a, r_k,
           lnx_g, lnx_b, w_out, w_gate, w_up, w_down):
    mod = jax.nn.silu(c) @ w_mod + b_mod
    sh1, sc1, ga1, sh2, sc2, ga2 = [m[:, None, :] for m in jnp.split(mod, 6, axis=-1)]
    h = _rms_norm(x, g_mix_pre) * (1.0 + sc1) + sh1
    u = h @ w_in
    conv_out, new_buf = _conv_mix(u[..., :2 * D_CONV], conv_buf, conv_dw, conv_b, conv_ln_g, conv_ln_b)
    rwkv_out, new_shift, new_wkv = _rwkv_mix(u[..., 2 * D_CONV:], shift_prev, wkv, mu_shift, w0, w2,
                                             a0, a2, g2, k_k, k_a, r_k, lnx_g, lnx_b)
    mix = jnp.concatenate([conv_out, rwkv_out], axis=-1) @ w_out
    x = x + (1.0 + ga1) * _rms_norm(mix, g_mix_post)
    h = _rms_norm(x, g_ffn_pre) * (1.0 + sc2) + sh2
    f = (jax.nn.silu(h @ w_gate) * (h @ w_up)) @ w_down
    x = x + (1.0 + ga2) * _rms_norm(f, g_ffn_post)
    return x, new_buf, new_shift, new_wkv


def setup_inputs(seed: int = 0) -> dict:
    key = jax.random.key(seed)
    ks = iter(jax.random.split(key, 48))
    f32 = jnp.float32
    nrm = lambda shape, s: jax.random.normal(next(ks), shape, f32) * s
    L = DEPTH
    return {
        'x_prompt': nrm((BATCH, SEQ, D_MODEL), 1.0),
        'x_sample': nrm((DEC_BATCH, DEC_SEQ, D_MODEL), 1.0),
        'cache_conv': nrm((L, DEC_BATCH, CONV_BUF, D_CONV), 0.5),
        'state_shift': nrm((L, DEC_BATCH, D_SHIFT), 1.0),
        'state_wkv': nrm((L, DEC_BATCH, N_HEADS, HEAD_DIM, HEAD_DIM), 0.3),
        'c_prompt': nrm((BATCH, D_MODEL), 1.0),
        'c_sample': nrm((DEC_BATCH, D_MODEL), 1.0),
        'w_mod': nrm((L, D_MODEL, 6 * D_MODEL), 0.1 * D_MODEL ** -0.5),
        'b_mod': nrm((L, 6 * D_MODEL), 0.01),
        'g_mix_pre': 1.0 + nrm((L, D_MODEL), 0.05),
        'g_mix_post': 1.0 + nrm((L, D_MODEL), 0.05),
        'g_ffn_pre': 1.0 + nrm((L, D_MODEL), 0.05),
        'g_ffn_post': 1.0 + nrm((L, D_MODEL), 0.05),
        'w_in': nrm((L, D_MODEL, D_IN), D_MODEL ** -0.5),
        'conv_dw': nrm((L, CONV_WIDTH, D_CONV), CONV_WIDTH ** -0.5),
        'conv_b': nrm((L, D_CONV), 0.01),
        'conv_ln_g': 1.0 + nrm((L, D_CONV), 0.05),
        'conv_ln_b': nrm((L, D_CONV), 0.01),
        'mu_shift': jax.random.uniform(next(ks), (L, D_SHIFT), f32),
        'w0': jax.random.uniform(next(ks), (L, D_RWKV), f32, -5.0, 1.0),
        'w2': nrm((L, LORA_W, D_RWKV), 0.5 * LORA_W ** -0.5),
        'a0': nrm((L, D_RWKV), 0.3),
        'a2': nrm((L, LORA_A, D_RWKV), 0.5 * LORA_A ** -0.5),
        'g2': nrm((L, LORA_G, D_RWKV), LORA_G ** -0.5),
        'k_k': 0.85 + nrm((L, D_RWKV), 0.05),
        'k_a': 1.0 + nrm((L, D_RWKV), 0.05),
        'r_k': nrm((L, N_HEADS, HEAD_DIM), 0.1),
        'lnx_g': 1.0 + nrm((L, D_RWKV), 0.05),
        'lnx_b': nrm((L, D_RWKV), 0.01),
        'w_out': nrm((L, D_MIX, D_MODEL), D_MIX ** -0.5),
        'w_gate': nrm((L, D_MODEL, D_FF), D_MODEL ** -0.5),
        'w_up': nrm((L, D_MODEL, D_FF), D_MODEL ** -0.5),
        'w_down': nrm((L, D_FF, D_MODEL), D_FF ** -0.5),
    }


def reference(x_prompt, x_sample, cache_conv, state_shift, state_wkv, c_prompt, c_sample,
              w_mod, b_mod, g_mix_pre, g_mix_post, g_ffn_pre, g_ffn_post, w_in, conv_dw, conv_b,
              conv_ln_g, conv_ln_b, mu_shift, w0, w2, a0, a2, g2, k_k, k_a, r_k, lnx_g, lnx_b,
              w_out, w_gate, w_up, w_down):
    weights = (w_mod, b_mod, g_mix_pre, g_mix_post, g_ffn_pre, g_ffn_post, w_in, conv_dw, conv_b,
               conv_ln_g, conv_ln_b, mu_shift, w0, w2, a0, a2, g2, k_k, k_a, r_k, lnx_g, lnx_b,
               w_out, w_gate, w_up, w_down)
    bp = x_prompt.shape[0]
    dt = x_prompt.dtype
    zero_conv = jnp.zeros((bp, CONV_BUF, D_CONV), dt)
    zero_shift = jnp.zeros((bp, D_SHIFT), dt)
    zero_wkv = jnp.zeros((bp, N_HEADS, HEAD_DIM, HEAD_DIM), dt)
    yp, ys = x_prompt, x_sample
    cp, sp, wp, cs, ss, wsm = [], [], [], [], [], []
    for l in range(DEPTH):
        lw = [w[l] for w in weights]
        yp, b1, s1, k1 = _layer(yp, c_prompt, zero_conv, zero_shift, zero_wkv, *lw)
        ys, b2, s2, k2 = _layer(ys, c_sample, cache_conv[l], state_shift[l], state_wkv[l], *lw)
        cp.append(b1); sp.append(s1); wp.append(k1)
        cs.append(b2); ss.append(s2); wsm.append(k2)
    conv_prompt, shift_prompt, wkv_prompt = jnp.stack(cp), jnp.stack(sp), jnp.stack(wp)
    conv_sample, shift_sample, wkv_sample = jnp.stack(cs), jnp.stack(ss), jnp.stack(wsm)
    return (yp, ys, conv_prompt, shift_prompt, wkv_prompt, conv_sample, shift_sample, wkv_sample)
```

```cpp
#include <hip/hip_runtime.h>
#include <hip/hip_cooperative_groups.h>
#include <cstdio>
#include <cstdint>
namespace cg = cooperative_groups;
namespace pg8 {
#define PG8_LAS __attribute__((address_space(3)))
typedef unsigned short bf16_t;
typedef short bf16x8 __attribute__((ext_vector_type(8)));
typedef float f32x4 __attribute__((ext_vector_type(4)));
typedef unsigned u32x4 __attribute__((ext_vector_type(4)));
constexpr int BM = 256, BK = 64, HALF = 128, HTB = HALF * BK * 2  , STAGE_BYTES = 8 * HTB, NXCD = 8, WGM = 8;

__host__ __device__ __forceinline__ int lds_byte(int r, int c) { const int st = (r >> 4) * 2 + (c >> 5), rr = r & 15, cc = c & 31, ob = rr * 64 + cc * 2; return st * 1024 + (ob ^ (((ob >> 9) & 1) << 5)); }
__host__ __device__ __forceinline__ void stage_rc(int b, int& R, int& C) { const int st = b / 1024, sb = b % 1024, swz = sb ^ (((sb >> 9) & 1) << 5); R = (st >> 1) * 16 + swz / 64; C = (st & 1) * 32 + (swz % 64) / 2; }
__host__ __device__ __forceinline__ int perm32(int rho) { const int n = rho >> 4, i = rho & 15; return 8 * (i >> 2) + 4 * n + (i & 3); }

struct Unit { int pm, pn; };
struct Gemm { const bf16_t* A; const bf16_t* Bt; int M, N, K; };

struct StaticOrder {
    int nM, nN, nwg, G, c;
    __host__ __device__ void init(int M, int N, int G_, int c_) { nM = M / BM; nN = N / BM; nwg = nM * nN; G = G_; c = c_; }
    __host__ __device__ bool next(int i, Unit& u) const {
        const long L = (long)i * G + c; if (L >= nwg) return false;
        int wgid = (int)L; { const int q = nwg / NXCD, r = nwg % NXCD, xcd = wgid % NXCD, off = wgid / NXCD; wgid = (xcd < r ? xcd * (q + 1) : r * (q + 1) + (xcd - r) * q) + off; }
        const int nig = WGM * nN, gid = wgid / nig, fm = gid * WGM, gsz = (nM - fm) < WGM ? (nM - fm) : WGM;
        u.pm = fm + ((wgid % nig) % gsz); u.pn = (wgid % nig) / gsz; return true;
    }
    __device__ __forceinline__ void a_ready(const Unit&) const {}
    __device__ __forceinline__ void done(const Unit&) const {}
};

__device__ __forceinline__ unsigned cvt_pk_bf16(float lo, float hi) { unsigned r; asm volatile("v_cvt_pk_bf16_f32 %0, %1, %2" : "=v"(r) : "v"(lo), "v"(hi)); return r; }
__device__ __forceinline__ float fsigmoid(float x) { return __builtin_amdgcn_rcpf(1.0f + __expf(-x)); }
struct EpiMulti {
    static constexpr bool PERM = true, AFTER_DRAIN = false;
    int mode; bf16_t* O; int ldc; float* F; const float* bw; const float* ba;
    __device__ __forceinline__ void operator()(const f32x4 (&acc)[2][2][4][2], const Unit& u, int wr, int wc, int fr, int fq) const {
        const int row0 = u.pm * BM + wr * 64 + fr;
        if (mode == 1) {
            const int col0 = u.pn * HALF + wc * 32 + 8 * fq;
#pragma unroll
            for (int ai = 0; ai < 2; ++ai)
#pragma unroll
                for (int m = 0; m < 4; ++m) { bf16_t* rowp = O + (size_t)(row0 + ai * HALF + m * 16) * ldc + col0;
                    float f[8];
#pragma unroll
                    for (int n = 0; n < 2; ++n)
#pragma unroll
                        for (int i = 0; i < 4; ++i) { const float g = acc[ai][0][m][n][i], up = acc[ai][1][m][n][i]; f[n * 4 + i] = g * fsigmoid(g) * up; }
                    u32x4 w; w.x = cvt_pk_bf16(f[0], f[1]); w.y = cvt_pk_bf16(f[2], f[3]); w.z = cvt_pk_bf16(f[4], f[5]); w.w = cvt_pk_bf16(f[6], f[7]);
                    *(u32x4*)rowp = w; }
        } else if (mode == 2 && u.pn < 2) {
            const int col0 = u.pn * BM + wc * 32 + 8 * fq;
#pragma unroll
            for (int ai = 0; ai < 2; ++ai)
#pragma unroll
                for (int m = 0; m < 4; ++m) { float* rowp = F + (size_t)(row0 + ai * HALF + m * 16) * 512 + col0;
#pragma unroll
                    for (int bj = 0; bj < 2; ++bj) { const f32x4 b0 = *(const f32x4*)(bw + col0 + bj * HALF), b1 = *(const f32x4*)(bw + col0 + bj * HALF + 4); f32x4 o0, o1;
#pragma unroll
                        for (int i = 0; i < 4; ++i) { o0[i] = 0.6065306597f * fsigmoid(acc[ai][bj][m][0][i] + b0[i]); o1[i] = 0.6065306597f * fsigmoid(acc[ai][bj][m][1][i] + b1[i]); }
                        *(f32x4*)(rowp + bj * HALF) = o0; *(f32x4*)(rowp + bj * HALF + 4) = o1; } }
        } else {
            const int col0 = (mode == 2 ? (u.pn - 2) : u.pn) * BM + wc * 32 + 8 * fq;
#pragma unroll
            for (int ai = 0; ai < 2; ++ai)
#pragma unroll
                for (int m = 0; m < 4; ++m) { bf16_t* rowp = O + (size_t)(row0 + ai * HALF + m * 16) * ldc + col0;
#pragma unroll
                    for (int bj = 0; bj < 2; ++bj) { f32x4 v0 = acc[ai][bj][m][0], v1 = acc[ai][bj][m][1];
                        if (mode == 2 && u.pn < 4) { const f32x4 b0 = *(const f32x4*)(ba + col0 + bj * HALF), b1 = *(const f32x4*)(ba + col0 + bj * HALF + 4);
#pragma unroll
                            for (int i = 0; i < 4; ++i) { v0[i] = fsigmoid(v0[i] + b0[i]); v1[i] = fsigmoid(v1[i] + b1[i]); } }
                        u32x4 w; w.x = cvt_pk_bf16(v0[0], v0[1]); w.y = cvt_pk_bf16(v0[2], v0[3]); w.z = cvt_pk_bf16(v1[0], v1[1]); w.w = cvt_pk_bf16(v1[2], v1[3]);
                        *(u32x4*)(rowp + bj * HALF) = w; } }
        }
    }
};

template <class Epi, class Sched, bool ALIGN_EPI = false, bool SP2 = false>
__device__ __forceinline__ void gemm_phase(PG8_LAS unsigned char* lds, const Gemm g, const Sched& S, const Epi& E) {
    int tid_l = threadIdx.x; asm volatile("" : "+v"(tid_l));
    const int tid = tid_l, wid = __builtin_amdgcn_readfirstlane(tid >> 6), lane = tid & 63, wr = wid >> 2, wc = wid & 3, fr = lane & 15, fq = lane >> 4;
    const int K = g.K, nt = K / BK;
    unsigned voffA[2], voffB[2];
#pragma unroll
    for (int i = 0; i < 2; ++i) { int R, C; stage_rc(tid * 16 + i * 8192, R, C); const int Rb = Epi::PERM ? ((R & ~31) + perm32(R & 31)) : R;
        voffA[i] = (unsigned)(R * K + C) * 2u; voffB[i] = (unsigned)(Rb * K + C) * 2u; }
    const size_t kstep = (size_t)(BK * 2);
    const size_t hstep = (size_t)HALF * K * 2;
    const size_t tstep = 2 * hstep;
    const unsigned ldsw = (unsigned)wid * 1024u;
    const int aoff = lds_byte(wr * 64 + fr, fq * 8), boff = lds_byte(wc * 32 + fr, fq * 8);
#define PG8_SA(b, h) (((b) * 2 + (h)) * HTB)
#define PG8_SB(b, h) ((4 + (b) * 2 + (h)) * HTB)
#define PG8_STAGE(bufoff, gbase, voff) do { _Pragma("unroll") for (int _i = 0; _i < 2; ++_i) \
        __builtin_amdgcn_global_load_lds((const unsigned*)((const char*)(gbase) + (voff)[_i]), (PG8_LAS unsigned*)(lds + (bufoff) + ldsw + _i * 8192), 16, 0, 0); } while (0)
#define PG8_LDA(dst, b, h) do { _Pragma("unroll") for (int m = 0; m < 4; ++m) _Pragma("unroll") for (int k = 0; k < 2; ++k) dst[m][k] = *(const PG8_LAS bf16x8*)(lds + PG8_SA(b, h) + aoff + m * 2048 + k * 1024); } while (0)
#define PG8_LDB(dst, b, h) do { _Pragma("unroll") for (int n = 0; n < 2; ++n) _Pragma("unroll") for (int k = 0; k < 2; ++k) dst[n][k] = *(const PG8_LAS bf16x8*)(lds + PG8_SB(b, h) + boff + n * 2048 + k * 1024); } while (0)
#define PG8_MMA(ai, bj, At, Bt) do { __builtin_amdgcn_s_setprio(1); _Pragma("unroll") for (int m = 0; m < 4; ++m) _Pragma("unroll") for (int n = 0; n < 2; ++n) _Pragma("unroll") for (int k = 0; k < 2; ++k) \
        acc[ai][bj][m][n] = __builtin_amdgcn_mfma_f32_16x16x32_bf16(Bt[n][k], At[m][k], acc[ai][bj][m][n], 0, 0, 0); __builtin_amdgcn_s_setprio(0); } while (0)
#define PG8_WAIT_V(n) asm volatile("s_waitcnt vmcnt(" #n ")" ::: "memory")
#define PG8_WAIT_L(n) asm volatile("s_waitcnt lgkmcnt(" #n ")" ::: "memory")
#define PG8_BAR __builtin_amdgcn_s_barrier()
#define PG8_SCHED __builtin_amdgcn_sched_barrier(0)
    Unit cur, nxt; int ui = 0;
    if (!S.next(0, cur)) return;
    f32x4 acc[2][2][4][2];
#pragma unroll
    for (int a = 0; a < 2; ++a)
#pragma unroll
        for (int b = 0; b < 2; ++b)
#pragma unroll
            for (int m = 0; m < 4; ++m)
#pragma unroll
                for (int n = 0; n < 2; ++n) acc[a][b][m][n] = (f32x4){0.f, 0.f, 0.f, 0.f};
    bf16x8 At[4][2], B0[2][2], B1[2][2];
    const char* cA = (const char*)g.A + (size_t)cur.pm * tstep; const char* cB = (const char*)g.Bt + (size_t)cur.pn * tstep;
    S.a_ready(cur);
    if constexpr (SP2) {
        PG8_STAGE(PG8_SB(0, 0), cB, voffB); PG8_STAGE(PG8_SB(0, 1), cB + hstep, voffB); PG8_STAGE(PG8_SA(0, 0), cA, voffA); PG8_STAGE(PG8_SA(0, 1), cA + hstep, voffA);
        if (wr == 1) PG8_BAR;
        PG8_WAIT_V(2); PG8_BAR;
        PG8_STAGE(PG8_SB(1, 0), cB + kstep, voffB); PG8_STAGE(PG8_SA(1, 0), cA + kstep, voffA); PG8_STAGE(PG8_SB(1, 1), cB + hstep + kstep, voffB);
        PG8_WAIT_V(6); PG8_BAR;
    } else {
        PG8_STAGE(PG8_SB(0, 0), cB, voffB); PG8_STAGE(PG8_SA(0, 0), cA, voffA); PG8_STAGE(PG8_SB(0, 1), cB + hstep, voffB); PG8_STAGE(PG8_SA(0, 1), cA + hstep, voffA);
        if (wr == 1) PG8_BAR;
        PG8_WAIT_V(4); PG8_BAR;
        PG8_STAGE(PG8_SB(1, 0), cB + kstep, voffB); PG8_STAGE(PG8_SA(1, 0), cA + kstep, voffA); PG8_STAGE(PG8_SB(1, 1), cB + hstep + kstep, voffB);
        PG8_WAIT_V(6); PG8_BAR;
    }
    for (;;) {
        const bool has_next = S.next(ui + 1, nxt);
        const char* nA = has_next ? (const char*)g.A + (size_t)nxt.pm * tstep : cA; const char* nB = has_next ? (const char*)g.Bt + (size_t)nxt.pn * tstep : cB;
        for (int t = 0; t < nt; t += 2) {
            const bool last = (t == nt - 2);
            const char* a1 = cA + (size_t)(t + 1) * kstep;
            const char* a2 = last ? nA : cA + (size_t)(t + 2) * kstep; const char* b2 = last ? nB : cB + (size_t)(t + 2) * kstep;
            const char* a3 = a2 + kstep; const char* b3 = b2 + kstep;
            if (last && has_next) S.a_ready(nxt);
            if constexpr (SP2) {
            PG8_LDB(B0, 0, 0); PG8_LDB(B1, 0, 1); PG8_SCHED; PG8_LDA(At, 0, 0); PG8_STAGE(PG8_SA(1, 1), a1 + hstep, voffA);
            PG8_WAIT_V(8); PG8_WAIT_L(0); PG8_BAR; PG8_MMA(0, 0, At, B0); PG8_MMA(0, 1, At, B1); PG8_BAR; PG8_SCHED;
            PG8_LDA(At, 0, 1); PG8_STAGE(PG8_SB(0, 0), b2, voffB); PG8_STAGE(PG8_SB(0, 1), b2 + hstep, voffB); PG8_STAGE(PG8_SA(0, 0), a2, voffA);
            PG8_WAIT_V(8); PG8_WAIT_L(0); PG8_BAR; PG8_MMA(1, 0, At, B0); PG8_MMA(1, 1, At, B1); PG8_BAR; PG8_SCHED;
            PG8_LDB(B0, 1, 0); PG8_LDB(B1, 1, 1); PG8_SCHED; PG8_LDA(At, 1, 0); PG8_STAGE(PG8_SA(0, 1), a2 + hstep, voffA);
            PG8_WAIT_V(8); PG8_WAIT_L(0); PG8_BAR; PG8_MMA(0, 0, At, B0); PG8_MMA(0, 1, At, B1); PG8_BAR; PG8_SCHED;
            PG8_LDA(At, 1, 1); PG8_STAGE(PG8_SB(1, 0), b3, voffB); PG8_STAGE(PG8_SB(1, 1), b3 + hstep, voffB); PG8_STAGE(PG8_SA(1, 0), a3, voffA);
            PG8_WAIT_V(8); PG8_WAIT_L(0); PG8_BAR; PG8_MMA(1, 0, At, B0); PG8_MMA(1, 1, At, B1); PG8_BAR; PG8_SCHED;
            } else {
            PG8_LDB(B0, 0, 0); PG8_SCHED; PG8_LDA(At, 0, 0); PG8_STAGE(PG8_SA(1, 1), a1 + hstep, voffA);
            PG8_WAIT_L(8); PG8_BAR; PG8_WAIT_L(0); PG8_MMA(0, 0, At, B0); PG8_BAR; PG8_SCHED;
            PG8_LDB(B1, 0, 1); PG8_STAGE(PG8_SB(0, 0), b2, voffB);
            PG8_BAR; PG8_WAIT_L(0); PG8_MMA(0, 1, At, B1); PG8_BAR;
            PG8_LDA(At, 0, 1); PG8_STAGE(PG8_SA(0, 0), a2, voffA);
            PG8_BAR; PG8_WAIT_L(0); PG8_MMA(1, 0, At, B0); PG8_BAR; PG8_SCHED;
            PG8_STAGE(PG8_SB(0, 1), b2 + hstep, voffB);
            PG8_WAIT_V(6); PG8_BAR; PG8_MMA(1, 1, At, B1); PG8_BAR;
            PG8_LDB(B0, 1, 0); PG8_SCHED; PG8_LDA(At, 1, 0); PG8_STAGE(PG8_SA(0, 1), a2 + hstep, voffA);
            PG8_WAIT_L(8); PG8_BAR; PG8_WAIT_L(0); PG8_MMA(0, 0, At, B0); PG8_BAR; PG8_SCHED;
            PG8_LDB(B1, 1, 1); PG8_STAGE(PG8_SB(1, 0), b3, voffB);
            PG8_BAR; PG8_WAIT_L(0); PG8_MMA(0, 1, At, B1); PG8_BAR;
            PG8_LDA(At, 1, 1); PG8_STAGE(PG8_SA(1, 0), a3, voffA);
            PG8_BAR; PG8_WAIT_L(0); PG8_MMA(1, 0, At, B0); PG8_BAR; PG8_SCHED;
            PG8_STAGE(PG8_SB(1, 1), b3 + hstep, voffB);
            PG8_WAIT_V(6); PG8_BAR; PG8_MMA(1, 1, At, B1); PG8_BAR;
            }
        }
        if constexpr (ALIGN_EPI) { if (wr == 0) PG8_BAR; }
        if constexpr (!Epi::AFTER_DRAIN) { E(acc, cur, wr, wc, fr, fq); S.done(cur); }
        if (!has_next) break;
#pragma unroll
        for (int a = 0; a < 2; ++a)
#pragma unroll
            for (int b = 0; b < 2; ++b)
#pragma unroll
                for (int m = 0; m < 4; ++m)
#pragma unroll
                    for (int n = 0; n < 2; ++n) acc[a][b][m][n] = (f32x4){0.f, 0.f, 0.f, 0.f};
        cur = nxt; cA = nA; cB = nB; ++ui;
        if constexpr (ALIGN_EPI) { if (wr == 1) PG8_BAR; }
    }
    PG8_WAIT_V(0);
    if constexpr (!ALIGN_EPI) { if (wr == 0) PG8_BAR; }
    PG8_BAR;
    if constexpr (Epi::AFTER_DRAIN) { E.fused(acc, cur, wr, wc, fr, fq, lds, wid, lane); S.done(cur); }
#undef PG8_SA
#undef PG8_SB
#undef PG8_STAGE
#undef PG8_LDA
#undef PG8_LDB
#undef PG8_MMA
#undef PG8_WAIT_V
#undef PG8_WAIT_L
#undef PG8_BAR
#undef PG8_SCHED
}
}

constexpr int NWAVES = 8, NTHR = 512;
constexpr int DM = 1024, NP = 65536, NS = 512, NTOK = NP + NS, TP = 4096, TS = 64, BP = 16, BS = 8, NB = BP + BS;
constexpr int DIN = 2816, DFF = 2816, DSH = 1792, DCV = 512, DRW = 512, CBUF = 30, CW = 31, NH = 8;
constexpr int LDS_BYTES = 147456;
constexpr size_t O_Y = 0, O_CONVP = 67633152, O_SHIFTP = 68124672, O_WKVP = 68182016, O_CONVS = 69230592, O_SHIFTS = 69476352, O_WKVS = 69505024;
constexpr size_t MiB = 1u << 20;
constexpr size_t SZ_U = (size_t)NTOK * DIN * 2;
constexpr size_t SZ_H = (size_t)NTOK * DM * 2;
constexpr size_t WS_MOD = 0;
constexpr size_t WS_RK = 2 * MiB;
constexpr size_t WS_WIN = 5 * MiB;
constexpr size_t WS_WOUT = 16 * MiB;
constexpr size_t WS_WGU = 20 * MiB;
constexpr size_t WS_WDN = 42 * MiB;
constexpr size_t WS_WLR = 53 * MiB;
constexpr size_t WS_U = 56 * MiB;
constexpr size_t WS_H = 411 * MiB;
constexpr size_t WS_TMP = 541 * MiB;
constexpr size_t WS_LA = 671 * MiB;
constexpr size_t WS_DEC = 704 * MiB;
constexpr size_t WS_AG = 834 * MiB;
constexpr size_t WS_END = 964 * MiB;
static_assert(WS_U + SZ_U <= WS_H && WS_H + SZ_H <= WS_TMP && WS_TMP + SZ_H <= WS_LA && WS_LA + (size_t)NTOK * 256 * 2 <= WS_DEC && WS_DEC + (size_t)NTOK * 512 * 4 <= WS_AG && WS_AG + SZ_H <= WS_END, "ws map");

#define LAS __attribute__((address_space(3)))
typedef unsigned short bf16;
typedef unsigned v4u __attribute__((ext_vector_type(4)));
typedef unsigned v2u __attribute__((ext_vector_type(2)));
typedef float f32x4 __attribute__((ext_vector_type(4)));
typedef float f32x2 __attribute__((ext_vector_type(2)));

struct Params {
    const float *x_prompt, *x_sample, *cache_conv, *state_shift, *state_wkv, *c_prompt, *c_sample;
    const float *w_mod, *b_mod, *g_mix_pre, *g_mix_post, *g_ffn_pre, *g_ffn_post, *w_in, *conv_dw, *conv_b, *conv_ln_g, *conv_ln_b;
    const float *mu_shift, *w0, *w2, *a0, *a2, *g2, *k_k, *k_a, *r_k, *lnx_g, *lnx_b, *w_out, *w_gate, *w_up, *w_down;
    float* out; unsigned char* ws;
};

__device__ __forceinline__ unsigned f2bf(float f) { unsigned u = __builtin_bit_cast(unsigned, f); return (u + 0x7fffu + ((u >> 16) & 1u)) >> 16; }
__device__ __forceinline__ unsigned pk2(float lo, float hi) { return f2bf(lo) | (f2bf(hi) << 16); }
__device__ __forceinline__ float bflo(unsigned w) { return __uint_as_float(w << 16); }
__device__ __forceinline__ float bfhi(unsigned w) { return __uint_as_float(w & 0xffff0000u); }
__device__ __forceinline__ float bf1(bf16 b) { return __uint_as_float((unsigned)b << 16); }
__device__ __forceinline__ float sigm(float x) { return __builtin_amdgcn_rcpf(1.0f + __expf(-x)); }
__device__ __forceinline__ float fma_s(float a, float b, float c) { float d; asm("v_fma_f32 %0, %1, %2, %3" : "=v"(d) : "v"(a), "v"(b), "v"(c)); return d; }
__device__ __forceinline__ float mul_s(float a, float b) { float d; asm("v_mul_f32_e32 %0, %1, %2" : "=v"(d) : "v"(a), "v"(b)); return d; }
__device__ __forceinline__ float sub_s(float a, float b) { float d; asm("v_sub_f32_e32 %0, %1, %2" : "=v"(d) : "v"(a), "v"(b)); return d; }
__device__ __forceinline__ float shfl_lane(float v, int srclane) { return __int_as_float(__builtin_amdgcn_ds_bpermute(srclane << 2, __float_as_int(v))); }
__device__ __forceinline__ float wave_sum(float v, int lane) {
#pragma unroll
    for (int o = 1; o < 64; o <<= 1) v += shfl_lane(v, lane ^ o);
    return v;
}
template <int CTRL> __device__ __forceinline__ float dppf(float x) { return __int_as_float(__builtin_amdgcn_update_dpp(0, __float_as_int(x), CTRL, 0xf, 0xf, true)); }
__device__ __forceinline__ float sum8(float x) { x += dppf<0xB1>(x); x += dppf<0x4E>(x); x += dppf<0x141>(x); return x; }
__device__ __forceinline__ float sum16(float x) { x = sum8(x); x += dppf<0x140>(x); return x; }
__device__ __forceinline__ void unpack8(const v4u w, float* f) { f[0] = bflo(w.x); f[1] = bfhi(w.x); f[2] = bflo(w.y); f[3] = bfhi(w.y); f[4] = bflo(w.z); f[5] = bfhi(w.z); f[6] = bflo(w.w); f[7] = bfhi(w.w); }
__device__ __forceinline__ v4u pack8(const float* f) { v4u w; w.x = pk2(f[0], f[1]); w.y = pk2(f[2], f[3]); w.z = pk2(f[4], f[5]); w.w = pk2(f[6], f[7]); return w; }


constexpr int PTAB_OFF = LDS_BYTES - 512;
__device__ __forceinline__ unsigned long long ldp_(LAS unsigned char* lds, int i) { const LAS unsigned* t = (const LAS unsigned*)(lds + PTAB_OFF) + 2 * i; const unsigned lo = __builtin_amdgcn_readfirstlane(t[0]), hi = __builtin_amdgcn_readfirstlane(t[1]); return ((unsigned long long)hi << 32) | lo; }
__device__ __forceinline__ Params load_params(LAS unsigned char* lds) { Params q;
    q.x_prompt = (const float*)(const __attribute__((address_space(1))) float*)ldp_(lds, 0);
    q.x_sample = (const float*)(const __attribute__((address_space(1))) float*)ldp_(lds, 1);
    q.cache_conv = (const float*)(const __attribute__((address_space(1))) float*)ldp_(lds, 2);
    q.state_shift = (const float*)(const __attribute__((address_space(1))) float*)ldp_(lds, 3);
    q.state_wkv = (const float*)(const __attribute__((address_space(1))) float*)ldp_(lds, 4);
    q.c_prompt = (const float*)(const __attribute__((address_space(1))) float*)ldp_(lds, 5);
    q.c_sample = (const float*)(const __attribute__((address_space(1))) float*)ldp_(lds, 6);
    q.w_mod = (const float*)(const __attribute__((address_space(1))) float*)ldp_(lds, 7);
    q.b_mod = (const float*)(const __attribute__((address_space(1))) float*)ldp_(lds, 8);
    q.g_mix_pre = (const float*)(const __attribute__((address_space(1))) float*)ldp_(lds, 9);
    q.g_mix_post = (const float*)(const __attribute__((address_space(1))) float*)ldp_(lds, 10);
    q.g_ffn_pre = (const float*)(const __attribute__((address_space(1))) float*)ldp_(lds, 11);
    q.g_ffn_post = (const float*)(const __attribute__((address_space(1))) float*)ldp_(lds, 12);
    q.w_in = (const float*)(const __attribute__((address_space(1))) float*)ldp_(lds, 13);
    q.conv_dw = (const float*)(const __attribute__((address_space(1))) float*)ldp_(lds, 14);
    q.conv_b = (const float*)(const __attribute__((address_space(1))) float*)ldp_(lds, 15);
    q.conv_ln_g = (const float*)(const __attribute__((address_space(1))) float*)ldp_(lds, 16);
    q.conv_ln_b = (const float*)(const __attribute__((address_space(1))) float*)ldp_(lds, 17);
    q.mu_shift = (const float*)(const __attribute__((address_space(1))) float*)ldp_(lds, 18);
    q.w0 = (const float*)(const __attribute__((address_space(1))) float*)ldp_(lds, 19);
    q.w2 = (const float*)(const __attribute__((address_space(1))) float*)ldp_(lds, 20);
    q.a0 = (const float*)(const __attribute__((address_space(1))) float*)ldp_(lds, 21);
    q.a2 = (const float*)(const __attribute__((address_space(1))) float*)ldp_(lds, 22);
    q.g2 = (const float*)(const __attribute__((address_space(1))) float*)ldp_(lds, 23);
    q.k_k = (const float*)(const __attribute__((address_space(1))) float*)ldp_(lds, 24);
    q.k_a = (const float*)(const __attribute__((address_space(1))) float*)ldp_(lds, 25);
    q.r_k = (const float*)(const __attribute__((address_space(1))) float*)ldp_(lds, 26);
    q.lnx_g = (const float*)(const __attribute__((address_space(1))) float*)ldp_(lds, 27);
    q.lnx_b = (const float*)(const __attribute__((address_space(1))) float*)ldp_(lds, 28);
    q.w_out = (const float*)(const __attribute__((address_space(1))) float*)ldp_(lds, 29);
    q.w_gate = (const float*)(const __attribute__((address_space(1))) float*)ldp_(lds, 30);
    q.w_up = (const float*)(const __attribute__((address_space(1))) float*)ldp_(lds, 31);
    q.w_down = (const float*)(const __attribute__((address_space(1))) float*)ldp_(lds, 32);
    q.out = (float*)(__attribute__((address_space(1))) float*)ldp_(lds, 33);
    q.ws = (unsigned char*)(__attribute__((address_space(1))) unsigned char*)ldp_(lds, 34);
    return q; }
__device__ __forceinline__ void store_params(const Params& p, LAS unsigned char* lds) { LAS unsigned long long* t = (LAS unsigned long long*)(lds + PTAB_OFF);
    t[0] = (unsigned long long)p.x_prompt;
    t[1] = (unsigned long long)p.x_sample;
    t[2] = (unsigned long long)p.cache_conv;
    t[3] = (unsigned long long)p.state_shift;
    t[4] = (unsigned long long)p.state_wkv;
    t[5] = (unsigned long long)p.c_prompt;
    t[6] = (unsigned long long)p.c_sample;
    t[7] = (unsigned long long)p.w_mod;
    t[8] = (unsigned long long)p.b_mod;
    t[9] = (unsigned long long)p.g_mix_pre;
    t[10] = (unsigned long long)p.g_mix_post;
    t[11] = (unsigned long long)p.g_ffn_pre;
    t[12] = (unsigned long long)p.g_ffn_post;
    t[13] = (unsigned long long)p.w_in;
    t[14] = (unsigned long long)p.conv_dw;
    t[15] = (unsigned long long)p.conv_b;
    t[16] = (unsigned long long)p.conv_ln_g;
    t[17] = (unsigned long long)p.conv_ln_b;
    t[18] = (unsigned long long)p.mu_shift;
    t[19] = (unsigned long long)p.w0;
    t[20] = (unsigned long long)p.w2;
    t[21] = (unsigned long long)p.a0;
    t[22] = (unsigned long long)p.a2;
    t[23] = (unsigned long long)p.g2;
    t[24] = (unsigned long long)p.k_k;
    t[25] = (unsigned long long)p.k_a;
    t[26] = (unsigned long long)p.r_k;
    t[27] = (unsigned long long)p.lnx_g;
    t[28] = (unsigned long long)p.lnx_b;
    t[29] = (unsigned long long)p.w_out;
    t[30] = (unsigned long long)p.w_gate;
    t[31] = (unsigned long long)p.w_up;
    t[32] = (unsigned long long)p.w_down;
    t[33] = (unsigned long long)p.out;
    t[34] = (unsigned long long)p.ws;
}

struct Tok { int b, t, bb, smp; };
__device__ __forceinline__ Tok tokinfo(int m) { Tok k; if (m < NP) { k.b = m >> 12; k.t = m & 4095; k.bb = k.b; k.smp = 0; } else { const int mm = m - NP; k.b = mm >> 6; k.t = mm & 63; k.bb = BP + k.b; k.smp = 1; } return k; }

template <int MODE>
__device__ __forceinline__ void transpose_item(const float* W, int K, int N, bf16* WT, LAS float* scr, int item, int lane) {
    const int nblk = N / 32, kb = item / nblk, nb = item % nblk, k0 = 64 * kb, n0 = 32 * nb;
#pragma unroll 8
    for (int i = 0; i < 32; ++i) { const int kk = 2 * i + (lane >> 5); scr[kk * 33 + (lane & 31)] = W[(size_t)(k0 + kk) * N + n0 + (lane & 31)]; }
    asm volatile("s_waitcnt lgkmcnt(0)" ::: "memory");
    const int c = lane & 7;
    const int rbase = (MODE == 0) ? n0 : ((n0 >> 7) * 256 + (MODE - 1) * 128 + (n0 & 127));
#pragma unroll
    for (int j = 0; j < 4; ++j) { const int n = (lane >> 3) + 8 * j; const LAS float* s = scr + (8 * c) * 33 + n;
        v4u o; o.x = pk2(s[0 * 33], s[1 * 33]); o.y = pk2(s[2 * 33], s[3 * 33]); o.z = pk2(s[4 * 33], s[5 * 33]); o.w = pk2(s[6 * 33], s[7 * 33]);
        *(v4u*)(WT + (size_t)(rbase + n) * K + k0 + 8 * c) = o; }
    asm volatile("s_waitcnt lgkmcnt(0)" ::: "memory");
}

__device__ __forceinline__ void phase_weights(LAS unsigned char* lds, int L, int wg0, int nwg) {
    const Params p = load_params(lds); int tid_ = threadIdx.x; asm volatile("" : "+v"(tid_)); const int tid = tid_, lane = tid & 63, wave = __builtin_amdgcn_readfirstlane(tid >> 6);
    LAS float* scr = (LAS float*)(lds + wave * 16384);
    const int gw = ((int)blockIdx.x - wg0) * NWAVES + wave, NGW = nwg * NWAVES;
    constexpr int I_IN = (DM / 64) * (DIN / 32), I_OUT = (DM / 64) * (DM / 32), I_G = (DM / 64) * (DFF / 32), I_DN = (DFF / 64) * (DM / 32);
    constexpr int PER_L = I_IN + I_OUT + 2 * I_G + I_DN;
    for (int it = gw; it < PER_L; it += NGW) {
        const int l = L; int r = it;
        if (r < I_IN) { transpose_item<0>(p.w_in + (size_t)l * DM * DIN, DM, DIN, (bf16*)(p.ws + WS_WIN) + (size_t)l * DIN * DM, scr, r, lane); continue; } r -= I_IN;
        if (r < I_OUT) { transpose_item<0>(p.w_out + (size_t)l * DM * DM, DM, DM, (bf16*)(p.ws + WS_WOUT) + (size_t)l * DM * DM, scr, r, lane); continue; } r -= I_OUT;
        if (r < I_G) { transpose_item<1>(p.w_gate + (size_t)l * DM * DFF, DM, DFF, (bf16*)(p.ws + WS_WGU) + (size_t)l * 2 * DFF * DM, scr, r, lane); continue; } r -= I_G;
        if (r < I_G) { transpose_item<2>(p.w_up + (size_t)l * DM * DFF, DM, DFF, (bf16*)(p.ws + WS_WGU) + (size_t)l * 2 * DFF * DM, scr, r, lane); continue; } r -= I_G;
        transpose_item<0>(p.w_down + (size_t)l * DFF * DM, DFF, DM, (bf16*)(p.ws + WS_WDN) + (size_t)l * DM * DFF, scr, r, lane);
    }
    bf16* WLR = (bf16*)(p.ws + WS_WLR);
    for (int i0 = ((int)blockIdx.x - wg0) * NTHR + tid; i0 < 1536 * 256; i0 += nwg * NTHR) {
        const int l = L, r = i0, i = L * 1536 * 256 + i0, n = r >> 8, k = r & 255; float v = 0.f;
        if (n < 512) { if (k < 64) v = p.w2[((size_t)l * 64 + k) * 512 + n]; }
        else if (n < 1024) { if (k >= 64 && k < 128) v = p.a2[((size_t)l * 64 + (k - 64)) * 512 + (n - 512)]; }
        else { if (k >= 128) v = p.g2[((size_t)l * 128 + (k - 128)) * 512 + (n - 1024)]; }
        WLR[i] = (bf16)f2bf(v);
    }
}

__device__ __forceinline__ void phase_mod(LAS unsigned char* lds, int wg0) {
    const Params p = load_params(lds); int tid_ = threadIdx.x; asm volatile("" : "+v"(tid_)); const int tid = tid_;
    const int u0 = (int)blockIdx.x - wg0; if (u0 < 0 || u0 >= 96) return;
    LAS float* sc = (LAS float*)lds;
    LAS float* red = (LAS float*)(lds + 24 * 1024 * 4);
    for (int i = tid; i < NB * DM; i += NTHR) { const int bb = i >> 10, e = i & 1023; const float c = bb < BP ? p.c_prompt[bb * DM + e] : p.c_sample[(bb - BP) * DM + e]; sc[i] = c * sigm(c); }
    __syncthreads();
    float* mod = (float*)(p.ws + WS_MOD);
    for (int unit = u0; unit < 96; unit += 96) {
        const int l = unit / 48, blk = unit % 48, kq = tid >> 7, cc = tid & 127, j = blk * 128 + cc;
        const float* W = p.w_mod + (size_t)l * DM * 6144 + j;
        float acc[NB];
#pragma unroll
        for (int bb = 0; bb < NB; ++bb) acc[bb] = 0.f;
        for (int i = kq * 256; i < kq * 256 + 256; i += 4) {
            const float w0 = W[(size_t)i * 6144], w1 = W[(size_t)(i + 1) * 6144], w2 = W[(size_t)(i + 2) * 6144], w3 = W[(size_t)(i + 3) * 6144];
#pragma unroll
            for (int bb = 0; bb < NB; ++bb) { const f32x4 s = *(const LAS f32x4*)(sc + bb * DM + i); acc[bb] += s.x * w0 + s.y * w1 + s.z * w2 + s.w * w3; }
        }
        if (kq > 0) {
#pragma unroll
            for (int bb = 0; bb < NB; ++bb) red[((kq - 1) * NB + bb) * 128 + cc] = acc[bb];
        }
        __syncthreads();
        if (kq == 0) {
            const float bm = p.b_mod[l * 6144 + j];
#pragma unroll
            for (int bb = 0; bb < NB; ++bb) mod[((size_t)l * NB + bb) * 6144 + j] = acc[bb] + red[(0 * NB + bb) * 128 + cc] + red[(1 * NB + bb) * 128 + cc] + red[(2 * NB + bb) * 128 + cc] + bm;
        }
        __syncthreads();
    }
}

template <int STAGE>
__device__ __forceinline__ void phase_rows(LAS unsigned char* lds, int l) {
    const Params p = load_params(lds); int tid_ = threadIdx.x; asm volatile("" : "+v"(tid_)); const int tid = tid_, lane = tid & 63, wave = __builtin_amdgcn_readfirstlane(tid >> 6);
    const int gw = blockIdx.x * NWAVES + wave, NGW = gridDim.x * NWAVES;
    const float* mod = (const float*)(p.ws + WS_MOD);
    bf16* H = (bf16*)(p.ws + WS_H); const bf16* TMP = (const bf16*)(p.ws + WS_TMP);
    constexpr int NR = 2;
    const bool x_from_in = (STAGE == 0 || (STAGE == 1 && l == 0));
    const float* gpost = (STAGE == 1 ? p.g_mix_post : p.g_ffn_post) + l * DM;
    const int ln = (STAGE == 2) ? l + 1 : l;
    const float* gpre = (STAGE == 1 ? p.g_ffn_pre : p.g_mix_pre) + ln * DM;
    const bool doH = !(STAGE == 2 && l == 1);
    f32x4 gpo[4], gpr[4];
#pragma unroll
    for (int j = 0; j < 4; ++j) { gpo[j] = (STAGE != 0) ? *(const f32x4*)(gpost + 4 * lane + 256 * j) : (f32x4){0.f, 0.f, 0.f, 0.f}; gpr[j] = doH ? *(const f32x4*)(gpre + 4 * lane + 256 * j) : (f32x4){0.f, 0.f, 0.f, 0.f}; }
    v2u nxb[NR][4], ntw[NR][4];
#define ROWS_PF(mb_) do { _Pragma("unroll") for (int r = 0; r < NR; ++r) { int m_ = (mb_) + r * NGW; if (m_ >= NTOK) m_ = gw; \
            if (!x_from_in) { const bf16* xb = (const bf16*)(p.out + (size_t)m_ * DM); _Pragma("unroll") for (int j = 0; j < 4; ++j) nxb[r][j] = __builtin_nontemporal_load((const v2u*)(xb + 4 * lane + 256 * j)); } \
            if (STAGE != 0) { _Pragma("unroll") for (int j = 0; j < 4; ++j) ntw[r][j] = __builtin_nontemporal_load((const v2u*)(TMP + (size_t)m_ * DM + 4 * lane + 256 * j)); } } } while (0)
    ROWS_PF(gw);
    for (int mb = gw; mb < NTOK; mb += NR * NGW) {
        int mm[NR]; bool ok[NR]; f32x4 v[NR][4], ga[NR][4], sh[NR][4], sc[NR][4]; v2u tw[NR][4];
#pragma unroll
        for (int r = 0; r < NR; ++r) { const int m = mb + r * NGW; ok[r] = m < NTOK; mm[r] = ok[r] ? m : mb; const int bb = tokinfo(mm[r]).bb;
#pragma unroll
            for (int j = 0; j < 4; ++j) { v[r][j] = (f32x4){bflo(nxb[r][j].x), bfhi(nxb[r][j].x), bflo(nxb[r][j].y), bfhi(nxb[r][j].y)}; tw[r][j] = ntw[r][j]; }
            if (x_from_in) { const float* xr = mm[r] < NP ? p.x_prompt + (size_t)mm[r] * DM : p.x_sample + (size_t)(mm[r] - NP) * DM;
#pragma unroll
                for (int j = 0; j < 4; ++j) v[r][j] = __builtin_nontemporal_load((const f32x4*)(xr + 4 * lane + 256 * j)); }
            if (STAGE != 0) { const float* mga = mod + ((size_t)l * NB + bb) * 6144 + (STAGE == 1 ? 2 : 5) * DM;
#pragma unroll
                for (int j = 0; j < 4; ++j) ga[r][j] = *(const f32x4*)(mga + 4 * lane + 256 * j); }
            if (doH) { const float* msh = mod + ((size_t)ln * NB + bb) * 6144 + (STAGE == 1 ? 3 : 0) * DM; const float* msc = mod + ((size_t)ln * NB + bb) * 6144 + (STAGE == 1 ? 4 : 1) * DM;
#pragma unroll
                for (int j = 0; j < 4; ++j) { sh[r][j] = *(const f32x4*)(msh + 4 * lane + 256 * j); sc[r][j] = *(const f32x4*)(msc + 4 * lane + 256 * j); } } }
        if (mb + NR * NGW < NTOK) ROWS_PF(mb + NR * NGW);
        if (STAGE != 0) {
            float ss[NR];
#pragma unroll
            for (int r = 0; r < NR; ++r) { ss[r] = 0.f;
#pragma unroll
                for (int j = 0; j < 4; ++j) { const float a = bflo(tw[r][j].x), b2 = bfhi(tw[r][j].x), c = bflo(tw[r][j].y), d = bfhi(tw[r][j].y); ss[r] += (a * a + b2 * b2) + (c * c + d * d); } }
#pragma unroll
            for (int r = 0; r < NR; ++r) ss[r] = wave_sum(ss[r], lane);
#pragma unroll
            for (int r = 0; r < NR; ++r) { const float rs = 1.0f / sqrtf(ss[r] * (1.0f / DM) + 1e-6f);
#pragma unroll
                for (int j = 0; j < 4; ++j) { const f32x4 tv = (f32x4){bflo(tw[r][j].x), bfhi(tw[r][j].x), bflo(tw[r][j].y), bfhi(tw[r][j].y)};
                    v[r][j] = v[r][j] + (1.0f + ga[r][j]) * (tv * rs * gpo[j]);
                    if (ok[r]) { if (STAGE == 2 && l == 1) __builtin_nontemporal_store(v[r][j], (f32x4*)(p.out + (size_t)mm[r] * DM + 4 * lane + 256 * j));
                        else { v2u w; w.x = pk2(v[r][j].x, v[r][j].y); w.y = pk2(v[r][j].z, v[r][j].w); *(v2u*)((bf16*)(p.out + (size_t)mm[r] * DM) + 4 * lane + 256 * j) = w;
                            v[r][j] = (f32x4){bflo(w.x), bfhi(w.x), bflo(w.y), bfhi(w.y)}; } } } }
        }
        if (doH) {
            float ss[NR];
#pragma unroll
            for (int r = 0; r < NR; ++r) { ss[r] = 0.f;
#pragma unroll
                for (int j = 0; j < 4; ++j) ss[r] += (v[r][j].x * v[r][j].x + v[r][j].y * v[r][j].y) + (v[r][j].z * v[r][j].z + v[r][j].w * v[r][j].w); }
#pragma unroll
            for (int r = 0; r < NR; ++r) ss[r] = wave_sum(ss[r], lane);
#pragma unroll
            for (int r = 0; r < NR; ++r) { const float rs = 1.0f / sqrtf(ss[r] * (1.0f / DM) + 1e-6f);
#pragma unroll
                for (int j = 0; j < 4; ++j) { const f32x4 h = (v[r][j] * rs * gpr[j]) * (1.0f + sc[r][j]) + sh[r][j];
                    v2u w; w.x = pk2(h.x, h.y); w.y = pk2(h.z, h.w);
                    if (ok[r]) *(v2u*)(H + (size_t)mm[r] * DM + 4 * lane + 256 * j) = w; } }
        }
    }
#undef ROWS_PF
}

#define XB_TMO      128
#define XB_XCNT(j)  (256  + 64 * (j))
#define XB_XSUB(j)  (1280 + 64 * (j))
#define XB_XGEN(j)  (2304 + 64 * (j))
#define XB_TOP      3328
#define XB_TOPGEN   3392
#define XCD_BAR_WORDS 3456
#define XB_SPIN_CAP (1u << 18)

__device__ __forceinline__ unsigned xb_ld(unsigned* p)              { return __hip_atomic_load(p, __ATOMIC_RELAXED, __HIP_MEMORY_SCOPE_AGENT); }
__device__ __forceinline__ unsigned xb_add(unsigned* p, unsigned v) { return __hip_atomic_fetch_add(p, v, __ATOMIC_RELAXED, __HIP_MEMORY_SCOPE_AGENT); }
__device__ __forceinline__ unsigned xb_xcc_id() { return (unsigned)__builtin_amdgcn_s_getreg((3 << 11) | 20) & 0xFu; }
#define XB_SPIN(cond, bar) do { unsigned _sp = 0; while (cond) { __builtin_amdgcn_s_sleep(1); \
    if ((++_sp & 255u) == 0u) { if (xb_ld(&(bar)[XB_TMO])) break; if (_sp > XB_SPIN_CAP) { atomicAdd(&(bar)[XB_TMO], 1u); break; } } } } while (0)

struct XcdBarrier {
    unsigned* bar; unsigned x;
    volatile LAS unsigned* st;
};

__device__ __forceinline__ XcdBarrier xcd_barrier_post(unsigned* bar, volatile LAS unsigned* st) {
    XcdBarrier b; b.bar = bar; b.x = xb_xcc_id(); b.st = st;
    if (threadIdx.x == 0) (void)xb_add(&bar[XB_XCNT(b.x)], 1u);
    return b;
}
__device__ __forceinline__ void xcd_barrier_complete(unsigned* bar, unsigned x, unsigned& nloc, unsigned& nx) {
    const unsigned G = gridDim.x * gridDim.y * gridDim.z;
    unsigned sum, cnt, mine, sp = 0u;
    for (;;) {
        sum = 0u; cnt = 0u; mine = 0u;
#pragma unroll
        for (unsigned j = 0; j < 16; ++j) { const unsigned c = xb_ld(&bar[XB_XCNT(j)]); sum += c; cnt += (c > 0u) ? 1u : 0u; mine = (j == x) ? c : mine; }
        if (sum == G) break;
        __builtin_amdgcn_s_sleep(1);
        if ((++sp & 255u) == 0u) { if (xb_ld(&bar[XB_TMO])) break; if (sp > XB_SPIN_CAP) { atomicAdd(&bar[XB_TMO], 1u); break; } }
    }
    nloc = mine > 0u ? mine : 1u; nx = cnt > 0u ? cnt : 1u;
}

__device__ __forceinline__ void xcd_barrier(const XcdBarrier& b) {
    asm volatile("s_waitcnt vmcnt(0)" ::: "memory");
    __syncthreads();
    if (threadIdx.x == 0) {
        unsigned* bar = b.bar;
        __builtin_amdgcn_s_waitcnt(0);
        unsigned nloc = b.st[0], nx = b.st[1];
        if (nloc == 0u) { xcd_barrier_complete(bar, b.x, nloc, nx); b.st[0] = nloc; b.st[1] = nx; }
        const unsigned old = xb_add(&bar[XB_XSUB(b.x)], 1u);
        const unsigned gen = old / nloc;
        if (old + 1u == (gen + 1u) * nloc) {
            __builtin_amdgcn_fence(__ATOMIC_RELEASE, "agent");
            asm volatile("s_waitcnt vmcnt(0)" ::: "memory");
            const unsigned og = xb_add(&bar[XB_TOP], 1u);
            const unsigned tg = og / nx;
            if (og + 1u == (tg + 1u) * nx) xb_add(&bar[XB_TOPGEN], 1u);
            else XB_SPIN(xb_ld(&bar[XB_TOPGEN]) == tg, bar);
            __builtin_amdgcn_fence(__ATOMIC_ACQUIRE, "agent");
            xb_add(&bar[XB_XGEN(b.x)], 1u);
            asm volatile("s_waitcnt vmcnt(0)" ::: "memory");
        } else {
            XB_SPIN(xb_ld(&bar[XB_XGEN(b.x)]) == gen, bar);
            __builtin_amdgcn_fence(__ATOMIC_ACQUIRE, "agent");
            asm volatile("s_waitcnt vmcnt(0)" ::: "memory");
        }
    }
    __syncthreads();
}


__device__ __forceinline__ void phase_conv(LAS unsigned char* lds, int l, unsigned* ctr) {
    const Params p = load_params(lds); int tid_ = threadIdx.x; asm volatile("" : "+v"(tid_)); const int tid = tid_, lane = tid & 63, wave = __builtin_amdgcn_readfirstlane(tid >> 6);
    LAS float* G = (LAS float*)lds;
    const bf16* U = (const bf16*)(p.ws + WS_U); bf16* MIX = (bf16*)(p.ws + WS_H);
    constexpr int NU = BP * (TP / 32) + BS * (TS / 32);
    float wj[CW];
#pragma unroll
    for (int j = 0; j < CW; ++j) wj[j] = p.conv_dw[((size_t)l * CW + j) * DCV + tid];
    const float cb = p.conv_b[l * DCV + tid];
    float lg[8], lb[8];
#pragma unroll
    for (int i = 0; i < 8; ++i) { lg[i] = p.conv_ln_g[l * DCV + 8 * lane + i]; lb[i] = p.conv_ln_b[l * DCV + 8 * lane + i]; }
    volatile LAS unsigned* tq = (volatile LAS unsigned*)(lds + PTAB_OFF + 416);
    for (;;) {
        if (tid == 0) tq[0] = __hip_atomic_fetch_add(ctr, 1u, __ATOMIC_RELAXED, __HIP_MEMORY_SCOPE_AGENT);
        __syncthreads();
        const int unit = (int)tq[0];
        __syncthreads();
        if (unit >= NU) break;
        int smp, b, t0, T, mbase;
        if (unit < BP * (TP / 32)) { smp = 0; b = unit >> 7; t0 = (unit & 127) * 32; T = TP; mbase = b * TP; }
        else { const int v = unit - BP * (TP / 32); smp = 1; b = v >> 1; t0 = (v & 1) * 32; T = TS; mbase = NP + b * TS; }
        const bool last = (t0 + 32 == T);
        float* cout = p.out + (smp ? O_CONVS + ((size_t)l * BS + b) * CBUF * DCV : O_CONVP + ((size_t)l * BP + b) * CBUF * DCV);
#pragma unroll 1
        for (int itb = tid; itb < 62 * 64; itb += 4 * NTHR) {
            v4u ua[4], us[4]; f32x4 c0[4], c1[4];
#pragma unroll
            for (int q = 0; q < 4; ++q) { const int it = itb + q * NTHR; const int i = it >> 6, c8 = it & 63, tok = t0 - CBUF + i;
                ua[q] = (v4u){0u, 0u, 0u, 0u}; us[q] = ua[q]; c0[q] = (f32x4){0.f, 0.f, 0.f, 0.f}; c1[q] = c0[q];
                if (it < 62 * 64) {
                    if (tok >= 0) { const bf16* ur = U + (size_t)(mbase + tok) * DIN + 8 * c8; ua[q] = *(const v4u*)ur; us[q] = *(const v4u*)(ur + DCV); }
                    else if (smp) { const float* cr = p.cache_conv + (((size_t)l * BS + b) * CBUF + (CBUF + tok)) * DCV + 8 * c8; c0[q] = *(const f32x4*)cr; c1[q] = *(const f32x4*)(cr + 4); } } }
#pragma unroll
            for (int q = 0; q < 4; ++q) { const int it = itb + q * NTHR; const int i = it >> 6, c8 = it & 63, tok = t0 - CBUF + i; float g[8];
                if (it < 62 * 64) {
                    if (tok >= 0) { float a[8], sg[8]; unpack8(ua[q], a); unpack8(us[q], sg);
#pragma unroll
                        for (int e = 0; e < 8; ++e) g[e] = a[e] * sigm(sg[e]); }
                    else { g[0] = c0[q].x; g[1] = c0[q].y; g[2] = c0[q].z; g[3] = c0[q].w; g[4] = c1[q].x; g[5] = c1[q].y; g[6] = c1[q].z; g[7] = c1[q].w; }
                    *(LAS f32x4*)(G + i * DCV + 8 * c8) = (f32x4){g[0], g[1], g[2], g[3]};
                    *(LAS f32x4*)(G + i * DCV + 8 * c8 + 4) = (f32x4){g[4], g[5], g[6], g[7]};
                    if (last && i >= 32) { float* o = cout + (size_t)(i - 32) * DCV + 8 * c8; *(f32x4*)o = (f32x4){g[0], g[1], g[2], g[3]}; *(f32x4*)(o + 4) = (f32x4){g[4], g[5], g[6], g[7]}; } } }
        }
        __syncthreads();
        float acc[32];
#pragma unroll
        for (int t = 0; t < 32; ++t) acc[t] = cb;
#pragma unroll
        for (int i = 0; i < 62; ++i) {
            const float g = G[i * DCV + tid];
#pragma unroll
            for (int t = 0; t < 32; ++t) { if (i - t >= 0 && i - t < CW) acc[t] += wj[i - t] * g; }
        }
        __syncthreads();
#pragma unroll
        for (int t = 0; t < 32; ++t) G[t * DCV + tid] = acc[t];
        __syncthreads();
#pragma unroll
        for (int q = 0; q < 4; ++q) {
            const int t = wave * 4 + q;
            const f32x4 y0 = *(const LAS f32x4*)(G + t * DCV + 8 * lane), y1 = *(const LAS f32x4*)(G + t * DCV + 8 * lane + 4);
            float y[8] = {y0.x, y0.y, y0.z, y0.w, y1.x, y1.y, y1.z, y1.w};
            float s = 0.f;
#pragma unroll
            for (int i = 0; i < 8; ++i) s += y[i];
            const float mean = wave_sum(s, lane) * (1.0f / DCV); float q2 = 0.f;
#pragma unroll
            for (int i = 0; i < 8; ++i) { y[i] -= mean; q2 += y[i] * y[i]; }
            const float rstd = 1.0f / sqrtf(wave_sum(q2, lane) * (1.0f / DCV) + 1e-5f);
            float o[8];
#pragma unroll
            for (int i = 0; i < 8; ++i) { const float z = y[i] * rstd * lg[i] + lb[i]; o[i] = z * sigm(z); }
            *(v4u*)(MIX + (size_t)(mbase + t0 + t) * DM + 8 * lane) = pack8(o);
        }
        __syncthreads();
    }
}

__device__ __forceinline__ void zprev8(const Params& p, int l, const bf16* U, int m, const Tok& k, int col, float* f) {
    if (k.t > 0) unpack8(*(const v4u*)(U + (size_t)(m - 1) * DIN + 1024 + col), f);
    else if (k.smp) { const float* s = p.state_shift + ((size_t)l * BS + k.b) * DSH + col; const f32x4 a = *(const f32x4*)s, b2 = *(const f32x4*)(s + 4);
        f[0] = a.x; f[1] = a.y; f[2] = a.z; f[3] = a.w; f[4] = b2.x; f[5] = b2.y; f[6] = b2.z; f[7] = b2.w; }
    else {
#pragma unroll
        for (int q = 0; q < 8; ++q) f[q] = 0.f; }
}

__device__ __forceinline__ void phase_prepA(LAS unsigned char* lds, int l) {
    const Params p = load_params(lds); int tid_ = threadIdx.x; asm volatile("" : "+v"(tid_)); const int tid = tid_;
    const bf16* U = (const bf16*)(p.ws + WS_U); bf16* LA = (bf16*)(p.ws + WS_LA);
    const int c8 = tid & 31, col = 1536 + 8 * c8;
    float mu[8];
#pragma unroll
    for (int q = 0; q < 8; ++q) mu[q] = p.mu_shift[(size_t)l * DSH + col + q];
    const int nstr = gridDim.x * NTHR;
    for (int itb = blockIdx.x * NTHR + tid; itb < NTOK * 32; itb += 4 * nstr) {
        v4u uz[4]; float zp[4][8]; bool ok[4]; int mm[4];
#pragma unroll
        for (int r = 0; r < 4; ++r) { const int it = itb + r * nstr; ok[r] = it < NTOK * 32; mm[r] = ok[r] ? (it >> 5) : (itb >> 5); const Tok k = tokinfo(mm[r]);
            uz[r] = *(const v4u*)(U + (size_t)mm[r] * DIN + 1024 + col); zprev8(p, l, U, mm[r], k, col, zp[r]); }
#pragma unroll
        for (int r = 0; r < 4; ++r) { float z[8], o[8]; unpack8(uz[r], z);
#pragma unroll
            for (int q = 0; q < 8; ++q) { const float zm = z[q] + (zp[r][q] - z[q]) * mu[q];
                o[q] = (c8 < 8) ? (1.0f - 2.0f * __builtin_amdgcn_rcpf(__expf(2.0f * zm) + 1.0f)) : (c8 < 16 ? zm : sigm(zm)); }
            if (ok[r]) *(v4u*)(LA + (size_t)mm[r] * 256 + 8 * c8) = pack8(o); }
    }
    for (int it = blockIdx.x * NTHR + tid; it < NB * DSH; it += gridDim.x * NTHR) {
        const int bb = it / DSH, col = it % DSH;
        if (bb < BP) p.out[O_SHIFTP + ((size_t)l * BP + bb) * DSH + col] = bf1(U[(size_t)(bb * TP + TP - 1) * DIN + 1024 + col]);
        else p.out[O_SHIFTS + ((size_t)l * BS + (bb - BP)) * DSH + col] = bf1(U[(size_t)(NP + (bb - BP) * TS + TS - 1) * DIN + 1024 + col]);
    }
}

struct ScanRegs { v2u zr, zk, zv, pr, pk, pv, av; f32x4 dec; float s_r[4], s_k[4], s_v[4]; };
__device__ __forceinline__ void phase_scan(LAS unsigned char* lds, int l) {
    const Params p = load_params(lds); int tid_ = threadIdx.x; asm volatile("" : "+v"(tid_)); const int tid = tid_;
    const bf16* U = (const bf16*)(p.ws + WS_U); const float* DEC = (const float*)(p.ws + WS_DEC); const bf16* AG = (const bf16*)(p.ws + WS_AG);
    float* Y = (float*)(p.ws + WS_TMP); float* RK = (float*)(p.ws + WS_RK);
    constexpr int TC = 32, VEC_F = 5 * TC * 64, BUF_F = VEC_F + TC * 32;
    LAS float* B0 = (LAS float*)lds;
    const int lane = tid & 63, wave = __builtin_amdgcn_readfirstlane(tid >> 6);
    const int ps = tid >> 4, kq = tid & 15, k0 = 4 * kq;
    for (int unit = blockIdx.x; unit < 384; unit += gridDim.x) {
        int smp, b, h, half, T, m0;
        if (unit < 256) { smp = 0; b = unit >> 4; h = (unit >> 1) & 7; half = unit & 1; T = TP; m0 = b * TP; }
        else { const int v = unit - 256; smp = 1; b = v >> 4; h = (v >> 1) & 7; half = v & 1; T = TS; m0 = NP + b * TS; }
        const int hc = h * 64 + k0;
        float mu_r[4], mu_k[4], mu_v[4], kkw[4], kaw[4], rkw[4], w0w[4], a0w[4];
#pragma unroll
        for (int j = 0; j < 4; ++j) { mu_r[j] = p.mu_shift[(size_t)l * DSH + hc + j]; mu_k[j] = p.mu_shift[(size_t)l * DSH + 512 + hc + j]; mu_v[j] = p.mu_shift[(size_t)l * DSH + 1024 + hc + j];
            kkw[j] = p.k_k[l * DRW + hc + j]; kaw[j] = p.k_a[l * DRW + hc + j]; rkw[j] = p.r_k[l * DRW + hc + j];  w0w[j] = p.w0[l * DRW + hc + j]; a0w[j] = p.a0[l * DRW + hc + j]; }
        float S[4];
        float* sout = p.out + (smp ? O_WKVS + (((size_t)l * BS + b) * NH + h) * 4096 : O_WKVP + (((size_t)l * BP + b) * NH + h) * 4096) + (size_t)(half * 32 + ps) * 64 + k0;
        if (smp) { const f32x4 s0 = *(const f32x4*)(p.state_wkv + (((size_t)l * BS + b) * NH + h) * 4096 + (size_t)(half * 32 + ps) * 64 + k0); S[0] = s0.x; S[1] = s0.y; S[2] = s0.z; S[3] = s0.w; }
        else { S[0] = S[1] = S[2] = S[3] = 0.f; }
        const int nch = T / TC;
        ScanRegs R;
#define SCAN_LOAD(c) do { const int t_ = (c) * TC + ps; const int m_ = m0 + t_; const bf16* ur_ = U + (size_t)m_ * DIN + 1024 + hc; \
            R.zr = *(const v2u*)ur_; R.zk = *(const v2u*)(ur_ + 512); R.zv = *(const v2u*)(ur_ + 1024); \
            if (t_ > 0) { R.pr = *(const v2u*)(ur_ - DIN); R.pk = *(const v2u*)(ur_ - DIN + 512); R.pv = *(const v2u*)(ur_ - DIN + 1024); } \
            else if (smp) { const float* s_ = p.state_shift + ((size_t)l * BS + b) * DSH + hc; \
                R.pr = (v2u){0u, 0u}; R.pk = (v2u){0u, 0u}; R.pv = (v2u){0u, 0u}; \
                R.s_r[0] = s_[0]; R.s_r[1] = s_[1]; R.s_r[2] = s_[2]; R.s_r[3] = s_[3]; R.s_k[0] = s_[512]; R.s_k[1] = s_[513]; R.s_k[2] = s_[514]; R.s_k[3] = s_[515]; \
                R.s_v[0] = s_[1024]; R.s_v[1] = s_[1025]; R.s_v[2] = s_[1026]; R.s_v[3] = s_[1027]; } \
            else { R.pr = (v2u){0u, 0u}; R.pk = (v2u){0u, 0u}; R.pv = (v2u){0u, 0u}; } \
            R.dec = *(const f32x4*)(DEC + (size_t)m_ * 512 + hc); R.av = *(const v2u*)(AG + (size_t)m_ * 1024 + hc); } while (0)
#define SCAN_FINISH(c, buf) do { LAS float* B_ = B0 + (buf) * BUF_F; const int t_ = (c) * TC + ps; const int m_ = m0 + t_; \
            float zr_[4] = {bflo(R.zr.x), bfhi(R.zr.x), bflo(R.zr.y), bfhi(R.zr.y)}, zk_[4] = {bflo(R.zk.x), bfhi(R.zk.x), bflo(R.zk.y), bfhi(R.zk.y)}, zv_[4] = {bflo(R.zv.x), bfhi(R.zv.x), bflo(R.zv.y), bfhi(R.zv.y)}; \
            float pr_[4] = {bflo(R.pr.x), bfhi(R.pr.x), bflo(R.pr.y), bfhi(R.pr.y)}, pk_[4] = {bflo(R.pk.x), bfhi(R.pk.x), bflo(R.pk.y), bfhi(R.pk.y)}, pv_[4] = {bflo(R.pv.x), bfhi(R.pv.x), bflo(R.pv.y), bfhi(R.pv.y)}; \
            if (smp && t_ == 0) { _Pragma("unroll") for (int j = 0; j < 4; ++j) { pr_[j] = R.s_r[j]; pk_[j] = R.s_k[j]; pv_[j] = R.s_v[j]; } } \
            const float a_[4] = {sigm(bflo(R.av.x) + a0w[0]), sigm(bfhi(R.av.x) + a0w[1]), sigm(bflo(R.av.y) + a0w[2]), sigm(bfhi(R.av.y) + a0w[3])}; \
            float r_[4], kr_[4], v_[4], kk_[4], kp_[4]; float ss_ = 0.f, rk_ = 0.f; \
            _Pragma("unroll") for (int j = 0; j < 4; ++j) { r_[j] = zr_[j] + (pr_[j] - zr_[j]) * mu_r[j]; kr_[j] = zk_[j] + (pk_[j] - zk_[j]) * mu_k[j]; v_[j] = zv_[j] + (pv_[j] - zv_[j]) * mu_v[j]; \
                kk_[j] = kr_[j] * kkw[j]; ss_ += kk_[j] * kk_[j]; kp_[j] = kr_[j] * (1.0f + (a_[j] - 1.0f) * kaw[j]); rk_ += r_[j] * kp_[j] * rkw[j]; } \
            ss_ = sum16(ss_); rk_ = sum16(rk_); const float rn_ = 1.0f / sqrtf(ss_ + 1e-12f); \
            _Pragma("unroll") for (int j = 0; j < 4; ++j) kk_[j] *= rn_; \
            *(LAS f32x4*)(B_ + (0 * TC + ps) * 64 + k0) = (f32x4){-kk_[0], -kk_[1], -kk_[2], -kk_[3]}; \
            *(LAS f32x4*)(B_ + (1 * TC + ps) * 64 + k0) = (f32x4){__expf(-0.6065306597f * sigm(R.dec.x + w0w[0])), __expf(-0.6065306597f * sigm(R.dec.y + w0w[1])), __expf(-0.6065306597f * sigm(R.dec.z + w0w[2])), __expf(-0.6065306597f * sigm(R.dec.w + w0w[3]))}; \
            *(LAS f32x4*)(B_ + (2 * TC + ps) * 64 + k0) = (f32x4){kk_[0] * a_[0], kk_[1] * a_[1], kk_[2] * a_[2], kk_[3] * a_[3]}; \
            *(LAS f32x4*)(B_ + (3 * TC + ps) * 64 + k0) = (f32x4){kp_[0], kp_[1], kp_[2], kp_[3]}; \
            *(LAS f32x4*)(B_ + (4 * TC + ps) * 64 + k0) = (f32x4){r_[0], r_[1], r_[2], r_[3]}; \
            if ((kq >> 3) == half) *(LAS f32x4*)(B_ + VEC_F + ps * 32 + (k0 - half * 32)) = (f32x4){v_[0], v_[1], v_[2], v_[3]}; \
            if (kq == 0 && half == 0) RK[(size_t)m_ * NH + h] = rk_; } while (0)
        SCAN_LOAD(0); SCAN_FINISH(0, 0);
        __syncthreads();
        float S0 = S[0], S1 = S[1], S2 = S[2], S3 = S[3];
        LAS float* PB = (LAS float*)lds + 2 * BUF_F + wave * 1024;
        for (int c = 0; c < nch; ++c) {
            const int buf = c & 1;
            if (c + 1 < nch) SCAN_LOAD(c + 1);
            const LAS float* B = B0 + buf * BUF_F;
#define SCAN_LDV(nk_, w_, ka_, kp_, r_, vv_, s_) do { nk_ = *(const LAS f32x4*)(B + (0 * TC + (s_)) * 64 + k0); w_ = *(const LAS f32x4*)(B + (1 * TC + (s_)) * 64 + k0); ka_ = *(const LAS f32x4*)(B + (2 * TC + (s_)) * 64 + k0); \
                kp_ = *(const LAS f32x4*)(B + (3 * TC + (s_)) * 64 + k0); r_ = *(const LAS f32x4*)(B + (4 * TC + (s_)) * 64 + k0); vv_ = B[VEC_F + (s_) * 32 + ps]; } while (0)
            f32x4 nk, w, ka, kp, r; float vv;
            SCAN_LDV(nk, w, ka, kp, r, vv, 0);
#pragma unroll
            for (int s = 0; s < TC; ++s) {
                f32x4 nk2, w2, ka2, kp2, r2; float vv2;
                if (s + 1 < TC) SCAN_LDV(nk2, w2, ka2, kp2, r2, vv2, s + 1);
                float sa = mul_s(S0, nk.x); sa = fma_s(S1, nk.y, sa); sa = fma_s(S2, nk.z, sa); sa = fma_s(S3, nk.w, sa);
                sa = sum16(sa);
                S0 = fma_s(vv, kp.x, fma_s(sa, ka.x, mul_s(S0, w.x))); S1 = fma_s(vv, kp.y, fma_s(sa, ka.y, mul_s(S1, w.y)));
                S2 = fma_s(vv, kp.z, fma_s(sa, ka.z, mul_s(S2, w.z))); S3 = fma_s(vv, kp.w, fma_s(sa, ka.w, mul_s(S3, w.w)));
                float yp = mul_s(S0, r.x); yp = fma_s(S1, r.y, yp); yp = fma_s(S2, r.z, yp); yp = fma_s(S3, r.w, yp);
                PB[(s & 15) * 64 + lane] = yp;
                if ((s & 15) == 15) {
                    const f32x4 q0 = *(const LAS f32x4*)(PB + lane * 16), q1 = *(const LAS f32x4*)(PB + lane * 16 + 4), q2 = *(const LAS f32x4*)(PB + lane * 16 + 8), q3 = *(const LAS f32x4*)(PB + lane * 16 + 12);
                    const f32x4 qs = (q0 + q1) + (q2 + q3);
                    Y[(size_t)(m0 + c * TC + (s - 15) + (lane >> 2)) * 512 + h * 64 + half * 32 + 4 * wave + (lane & 3)] = (qs.x + qs.y) + (qs.z + qs.w);
                }
                if (s + 1 < TC) { nk = nk2; w = w2; ka = ka2; kp = kp2; r = r2; vv = vv2; }
            }
#undef SCAN_LDV
            if (c + 1 < nch) SCAN_FINISH(c + 1, buf ^ 1);
            __syncthreads();
        }
        S[0] = S0; S[1] = S1; S[2] = S2; S[3] = S3;
        *(f32x4*)sout = (f32x4){S[0], S[1], S[2], S[3]};
        __syncthreads();
#undef SCAN_LOAD
#undef SCAN_FINISH
    }
}

__device__ __forceinline__ void phase_post(LAS unsigned char* lds, int l) {
    const Params p = load_params(lds); int tid_ = threadIdx.x; asm volatile("" : "+v"(tid_)); const int tid = tid_, lane = tid & 63, wave = __builtin_amdgcn_readfirstlane(tid >> 6);
    const bf16* U = (const bf16*)(p.ws + WS_U); const bf16* AG = (const bf16*)(p.ws + WS_AG); const float* Y = (const float*)(p.ws + WS_TMP); const float* RK = (const float*)(p.ws + WS_RK);
    bf16* MIX = (bf16*)(p.ws + WS_H);
    const int gw = blockIdx.x * NWAVES + wave, NGW = gridDim.x * NWAVES, ch = 8 * lane, h = lane >> 3;
    float lg[8], lb[8], mu[8];
#pragma unroll
    for (int i = 0; i < 8; ++i) { lg[i] = p.lnx_g[l * DRW + ch + i]; lb[i] = p.lnx_b[l * DRW + ch + i]; mu[i] = p.mu_shift[(size_t)l * DSH + 1024 + ch + i]; }
    constexpr int NR = 2;
    f32x4 ny0[NR], ny1[NR]; v4u nuz[NR], nug[NR];
#define POST_PF(mb_) do { _Pragma("unroll") for (int r = 0; r < NR; ++r) { int m_ = (mb_) + r * NGW; if (m_ >= NTOK) m_ = gw; \
            ny0[r] = __builtin_nontemporal_load((const f32x4*)(Y + (size_t)m_ * 512 + ch)); ny1[r] = __builtin_nontemporal_load((const f32x4*)(Y + (size_t)m_ * 512 + ch + 4)); \
            nuz[r] = *(const v4u*)(U + (size_t)m_ * DIN + 1024 + 1024 + ch); nug[r] = __builtin_nontemporal_load((const v4u*)(AG + (size_t)m_ * 1024 + 512 + ch)); } } while (0)
    POST_PF(gw);
    for (int mb = gw; mb < NTOK; mb += NR * NGW) {
        int mm[NR]; bool ok[NR]; f32x4 y0[NR], y1[NR]; v4u uz[NR], ug[NR]; float zp[NR][8], rk[NR];
#pragma unroll
        for (int r = 0; r < NR; ++r) { const int m = mb + r * NGW; ok[r] = m < NTOK; mm[r] = ok[r] ? m : mb; const Tok k = tokinfo(mm[r]);
            y0[r] = ny0[r]; y1[r] = ny1[r]; uz[r] = nuz[r]; ug[r] = nug[r];
            zprev8(p, l, U, mm[r], k, 1024 + ch, zp[r]); rk[r] = RK[(size_t)mm[r] * NH + h]; }
        if (mb + NR * NGW < NTOK) POST_PF(mb + NR * NGW);
#pragma unroll
        for (int r = 0; r < NR; ++r) {
            float y[8] = {y0[r].x, y0[r].y, y0[r].z, y0[r].w, y1[r].x, y1[r].y, y1[r].z, y1[r].w};
            float zv[8], g[8]; unpack8(uz[r], zv); unpack8(ug[r], g);
            float s = 0.f;
#pragma unroll
            for (int i = 0; i < 8; ++i) s += y[i];
            const float mean = sum8(s) * (1.0f / 64.0f); float q2 = 0.f;
#pragma unroll
            for (int i = 0; i < 8; ++i) { y[i] -= mean; q2 += y[i] * y[i]; }
            const float rstd = 1.0f / sqrtf(sum8(q2) * (1.0f / 64.0f) + 64e-5f);
            float o[8];
#pragma unroll
            for (int i = 0; i < 8; ++i) { const float v = zv[i] + (zp[r][i] - zv[i]) * mu[i]; o[i] = ((y[i] * rstd * lg[i] + lb[i]) + rk[r] * v) * g[i]; }
            if (ok[r]) *(v4u*)(MIX + (size_t)mm[r] * DM + 512 + ch) = pack8(o);
        }
    }
}

constexpr int SC_SLOT = 14976, SC_GAB = 12928, SC_GAK = 13952, SC_AT = 0, SC_RT = 2048, SC_BK = 4096, SC_VT = 8448, SC_TT = 10624, SC_GG = 11648, SC_PC = 12672;
__device__ __forceinline__ int bk_off(int kap, int gg) { return (kap >> 2) * 272 + (kap & 3) * 64 + gg * 16; }
__device__ __forceinline__ int vt_off(int v, int gg) { return (v >> 2) * 136 + (v & 3) * 32 + gg * 8; }
constexpr int SC_SCR = 8 * SC_SLOT, SC_SCRSZ = 6144, SC_BT = 0, SC_KT = 2048, SC_CST = 4096;
static_assert(SC_SCR + 4 * SC_SCRSZ <= LDS_BYTES - 512, "scan LDS map");
typedef short s16x8 __attribute__((ext_vector_type(8)));
typedef __bf16 bf16x2_t __attribute__((ext_vector_type(2)));
__device__ __forceinline__ unsigned cvtpk(float lo, float hi) { f32x2 v = (f32x2){lo, hi}; bf16x2_t b2 = __builtin_convertvector(v, bf16x2_t); return __builtin_bit_cast(unsigned, b2); }
__device__ __forceinline__ s16x8 mk8(unsigned a, unsigned b, unsigned c, unsigned d) { v4u w = (v4u){a, b, c, d}; return __builtin_bit_cast(s16x8, w); }

#define SC_BAR() do { asm volatile("s_waitcnt lgkmcnt(0)" ::: "memory"); __builtin_amdgcn_s_barrier(); asm volatile("" ::: "memory"); } while (0)
__device__ __forceinline__ void phase_scan2(LAS unsigned char* lds, int l) {
    const Params p = load_params(lds); int tid_ = threadIdx.x; asm volatile("" : "+v"(tid_)); const int tid = tid_;
    const bf16* U = (const bf16*)(p.ws + WS_U); const float* DEC = (const float*)(p.ws + WS_DEC); const bf16* AG = (const bf16*)(p.ws + WS_AG);
    float* Y = (float*)(p.ws + WS_TMP); float* RK = (float*)(p.ws + WS_RK);
    const int lane = tid & 63, wave = __builtin_amdgcn_readfirstlane(tid >> 6);
    const int li = lane & 15, g = lane >> 4;
    for (int unit = blockIdx.x; unit < 192; unit += gridDim.x) {
        int smp, b, h, T, m0;
        if (unit < 128) { smp = 0; b = unit >> 3; h = unit & 7; T = TP; m0 = b * TP; }
        else { const int v = unit - 128; smp = 1; b = v >> 3; h = v & 7; T = TS; m0 = NP + b * TS; }
        const int nR = T / 64;
        if (wave >= 4) {
            const int pw = wave - 4, kq = li, tg = g, k0 = 4 * kq, hc = h * 64 + k0;
            LAS unsigned char* scr = lds + SC_SCR + pw * SC_SCRSZ;
            const int ks = k0 >> 5, khalf = (k0 & 31) >> 4, kg = (k0 & 15) >> 2;
#define SC_LOADS(cc) do { _Pragma("unroll") for (int q = 0; q < 4; ++q) { const int t_ = (cc) * 16 + 4 * tg + q, m_ = m0 + t_; const bf16* ur_ = U + (size_t)m_ * DIN + 1024 + hc; \
                    zr[q] = *(const v2u*)ur_; zk[q] = *(const v2u*)(ur_ + 512); zv[q] = *(const v2u*)(ur_ + 1024); \
                    if (q == 0) { if (t_ > 0) { pr0 = *(const v2u*)(ur_ - DIN); pk0 = *(const v2u*)(ur_ - DIN + 512); pv0 = *(const v2u*)(ur_ - DIN + 1024); } \
                        else { pr0 = (v2u){0u, 0u}; pk0 = (v2u){0u, 0u}; pv0 = (v2u){0u, 0u}; } } \
                    dec[q] = *(const f32x4*)(DEC + (size_t)m_ * 512 + hc); av[q] = *(const v2u*)(AG + (size_t)m_ * 1024 + hc); } } while (0)
            v2u zr[4], zk[4], zv[4], pr0, pk0, pv0, av[4]; f32x4 dec[4];
            if (tg == 0) { LAS f32x4* ct = (LAS f32x4*)(scr + SC_CST + k0 * 4);
                ct[0] = *(const f32x4*)(p.mu_shift + (size_t)l * DSH + hc); ct[16] = *(const f32x4*)(p.mu_shift + (size_t)l * DSH + 512 + hc); ct[32] = *(const f32x4*)(p.mu_shift + (size_t)l * DSH + 1024 + hc);
                ct[48] = *(const f32x4*)(p.k_k + l * DRW + hc); ct[64] = *(const f32x4*)(p.k_a + l * DRW + hc); ct[80] = *(const f32x4*)(p.r_k + l * DRW + hc);
                ct[96] = *(const f32x4*)(p.w0 + l * DRW + hc); ct[112] = *(const f32x4*)(p.a0 + l * DRW + hc); }
            asm volatile("s_waitcnt lgkmcnt(0)" ::: "memory");
            SC_LOADS(pw);
            for (int R = -1; R + 1 < nR; ++R) {
                const int c = 4 * (R + 1) + pw;
                LAS unsigned char* slot = lds + (((R + 1) & 1) * 4 + pw) * SC_SLOT;
                float mu_r[4], mu_k[4], mu_v[4], kkw[4], kaw[4], rkw[4], w0w[4], a0w[4];
                { const LAS f32x4* ct = (const LAS f32x4*)(scr + SC_CST + k0 * 4);
                  const f32x4 c0 = ct[0], c1 = ct[16], c2 = ct[32], c3 = ct[48], c4 = ct[64], c5 = ct[80], c6 = ct[96], c7 = ct[112];
#pragma unroll
                  for (int j = 0; j < 4; ++j) { mu_r[j] = c0[j]; mu_k[j] = c1[j]; mu_v[j] = c2[j]; kkw[j] = c3[j]; kaw[j] = c4[j]; rkw[j] = c5[j]; w0w[j] = c6[j]; a0w[j] = c7[j]; } }
                float r_[4][4], kp_[4][4], v_[4][4], al_[4][4], be_[4][4], ce[4][4];
#pragma unroll
                for (int q = 0; q < 4; ++q) { const int t_ = c * 16 + 4 * tg + q, m_ = m0 + t_;
                    float zr_[4] = {bflo(zr[q].x), bfhi(zr[q].x), bflo(zr[q].y), bfhi(zr[q].y)}, zk_[4] = {bflo(zk[q].x), bfhi(zk[q].x), bflo(zk[q].y), bfhi(zk[q].y)}, zv_[4] = {bflo(zv[q].x), bfhi(zv[q].x), bflo(zv[q].y), bfhi(zv[q].y)};
                    const v2u prq = (q == 0) ? pr0 : zr[q > 0 ? q - 1 : 0], pkq = (q == 0) ? pk0 : zk[q > 0 ? q - 1 : 0], pvq = (q == 0) ? pv0 : zv[q > 0 ? q - 1 : 0];
                    float pr_[4] = {bflo(prq.x), bfhi(prq.x), bflo(prq.y), bfhi(prq.y)}, pk_[4] = {bflo(pkq.x), bfhi(pkq.x), bflo(pkq.y), bfhi(pkq.y)}, pv_[4] = {bflo(pvq.x), bfhi(pvq.x), bflo(pvq.y), bfhi(pvq.y)};
                    if (q == 0 && smp && t_ == 0) { const float* s_ = p.state_shift + (l * BS + b) * DSH + hc;
#pragma unroll
                        for (int j = 0; j < 4; ++j) { pr_[j] = s_[j]; pk_[j] = s_[512 + j]; pv_[j] = s_[1024 + j]; } }
                    const float a_[4] = {bflo(av[q].x), bfhi(av[q].x), bflo(av[q].y), bfhi(av[q].y)};
                    const float dq[4] = {dec[q].x, dec[q].y, dec[q].z, dec[q].w};
                    float kk_[4]; float ss_ = 0.f, rk_ = 0.f;
#pragma unroll
                    for (int j = 0; j < 4; ++j) { r_[q][j] = zr_[j] + (pr_[j] - zr_[j]) * mu_r[j]; const float kr = zk_[j] + (pk_[j] - zk_[j]) * mu_k[j]; v_[q][j] = zv_[j] + (pv_[j] - zv_[j]) * mu_v[j];
                        kk_[j] = kr * kkw[j]; ss_ += kk_[j] * kk_[j]; kp_[q][j] = kr * (1.0f + (a_[j] - 1.0f) * kaw[j]); rk_ += r_[q][j] * kp_[q][j] * rkw[j];
                        const float e = dq[j]; ce[q][j] = (q > 0 ? ce[q > 0 ? q - 1 : 0][j] : 0.f) + e; }
                    ss_ = sum16(ss_); rk_ = sum16(rk_); const float rn_ = __builtin_amdgcn_rsqf(ss_ + 1e-12f);
#pragma unroll
                    for (int j = 0; j < 4; ++j) { const float kn = kk_[j] * rn_; al_[q][j] = -kn; be_[q][j] = kn * a_[j]; }
                    if (kq == 0) RK[(size_t)m_ * NH + h] = rk_; }
                SC_BAR();
                float ex[4], l15[4];
                {
                    LAS f32x4* px = (LAS f32x4*)(scr + SC_BT);
                    px[tg * 16 + kq] = (f32x4){ce[3][0], ce[3][1], ce[3][2], ce[3][3]};
                    asm volatile("s_waitcnt lgkmcnt(0)" ::: "memory");
                    const f32x4 T0 = px[kq], T1 = px[16 + kq], T2 = px[32 + kq], T3 = px[48 + kq];
#pragma unroll
                    for (int j = 0; j < 4; ++j) { ex[j] = (tg >= 1 ? T0[j] : 0.f) + (tg >= 2 ? T1[j] : 0.f) + (tg >= 3 ? T2[j] : 0.f); l15[j] = -((T0[j] + T1[j]) + (T2[j] + T3[j])); }
                    asm volatile("s_waitcnt lgkmcnt(0)" ::: "memory");
                }
                unsigned bh[4][2], kh[4][2], vt[4][2];
                float Bh[4][4], Kh[4][4];
                float pin_[4][4], pc_[4], p0_[4];
#pragma unroll
                for (int j = 0; j < 4; ++j) { pc_[j] = __expf(l15[j]); p0_[j] = __expf(-ex[j]);
#pragma unroll
                    for (int q = 0; q < 4; ++q) pin_[q][j] = __expf(-(ex[j] + ce[q][j])); }
#pragma unroll
                for (int q = 0; q < 4; ++q) { const int i = 4 * tg + q; float At[4], Rt[4], Bt[4], Kt[4];
#pragma unroll
                    for (int j = 0; j < 4; ++j) { const float pin = pin_[q][j], ppr = (q > 0) ? pin_[q > 0 ? q - 1 : 0][j] : p0_[j], pinv = __builtin_amdgcn_rcpf(pin), phat = pc_[j] * pinv;
                        At[j] = al_[q][j] * ppr; Rt[j] = r_[q][j] * pin; Bt[j] = be_[q][j] * pinv; Kt[j] = kp_[q][j] * pinv; Bh[q][j] = be_[q][j] * phat; Kh[q][j] = kp_[q][j] * phat; }
                    const int off = (((i * 2 + ks) * 4 + kg) * 8 + khalf * 4) * 2;
                    *(LAS v2u*)(slot + SC_AT + off) = (v2u){cvtpk(At[0], At[1]), cvtpk(At[2], At[3])};
                    *(LAS v2u*)(slot + SC_RT + off) = (v2u){cvtpk(Rt[0], Rt[1]), cvtpk(Rt[2], Rt[3])};
                    *(LAS v2u*)(scr + SC_BT + off) = (v2u){cvtpk(Bt[0], Bt[1]), cvtpk(Bt[2], Bt[3])};
                    *(LAS v2u*)(scr + SC_KT + off) = (v2u){cvtpk(Kt[0], Kt[1]), cvtpk(Kt[2], Kt[3])}; }
#pragma unroll
                for (int jj = 0; jj < 4; ++jj) { const int kap = k0 + jj;
                    *(LAS v2u*)(slot + SC_BK + bk_off(kap, tg)) = (v2u){cvtpk(Bh[0][jj], Bh[1][jj]), cvtpk(Bh[2][jj], Bh[3][jj])};
                    *(LAS v2u*)(slot + SC_BK + bk_off(kap, tg) + 8) = (v2u){cvtpk(Kh[0][jj], Kh[1][jj]), cvtpk(Kh[2][jj], Kh[3][jj])};
                    *(LAS v2u*)(slot + SC_VT + vt_off(kap, tg)) = (v2u){cvtpk(v_[0][jj], v_[1][jj]), cvtpk(v_[2][jj], v_[3][jj])}; }
                if (tg == 0) *(LAS f32x4*)(slot + SC_PC + k0 * 4) = (f32x4){pc_[0], pc_[1], pc_[2], pc_[3]};
                asm volatile("s_waitcnt lgkmcnt(0)" ::: "memory");
                if (R + 2 < nR) SC_LOADS(c + 4);
                {
                    const int o0 = ((li * 2 + 0) * 4 + g) * 16, o1 = ((li * 2 + 1) * 4 + g) * 16;
                    const s16x8 aA0 = *(const LAS s16x8*)(slot + SC_AT + o0), aA1 = *(const LAS s16x8*)(slot + SC_AT + o1), aR0 = *(const LAS s16x8*)(slot + SC_RT + o0), aR1 = *(const LAS s16x8*)(slot + SC_RT + o1);
                    const s16x8 bB0 = *(const LAS s16x8*)(scr + SC_BT + o0), bB1 = *(const LAS s16x8*)(scr + SC_BT + o1), bK0 = *(const LAS s16x8*)(scr + SC_KT + o0), bK1 = *(const LAS s16x8*)(scr + SC_KT + o1);
                    const f32x4 z4 = (f32x4){0.f, 0.f, 0.f, 0.f};
                    f32x4 Gab = __builtin_amdgcn_mfma_f32_16x16x32_bf16(aA0, bB0, z4, 0, 0, 0); Gab = __builtin_amdgcn_mfma_f32_16x16x32_bf16(aA1, bB1, Gab, 0, 0, 0);
                    f32x4 Gak = __builtin_amdgcn_mfma_f32_16x16x32_bf16(aA0, bK0, z4, 0, 0, 0); Gak = __builtin_amdgcn_mfma_f32_16x16x32_bf16(aA1, bK1, Gak, 0, 0, 0);
                    f32x4 Grb = __builtin_amdgcn_mfma_f32_16x16x32_bf16(aR0, bB0, z4, 0, 0, 0); Grb = __builtin_amdgcn_mfma_f32_16x16x32_bf16(aR1, bB1, Grb, 0, 0, 0);
                    f32x4 Grk = __builtin_amdgcn_mfma_f32_16x16x32_bf16(aR0, bK0, z4, 0, 0, 0); Grk = __builtin_amdgcn_mfma_f32_16x16x32_bf16(aR1, bK1, Grk, 0, 0, 0);
#pragma unroll
                    for (int r = 0; r < 4; ++r) { const int i = 4 * g + r; const bool lo = li < i, le = li <= i;
                        *(LAS float*)(slot + SC_GAB + (i * 16 + li) * 4) = lo ? Gab[r] : 0.f; *(LAS float*)(slot + SC_GAK + (i * 16 + li) * 4) = lo ? Gak[r] : 0.f;
                        *(LAS bf16*)(slot + SC_GG + ((i * 4 + (li >> 2)) * 8 + (li & 3)) * 2) = (bf16)cvtpk(le ? Grb[r] : 0.f, 0.f);
                        *(LAS bf16*)(slot + SC_GG + ((i * 4 + (li >> 2)) * 8 + 4 + (li & 3)) * 2) = (bf16)cvtpk(le ? Grk[r] : 0.f, 0.f); }
                }
                SC_BAR();
            }
            SC_BAR(); SC_BAR();
        } else {
            const int v0 = 16 * wave;
            f32x4 St[4];
            const int sbase = ((smp ? l * BS + b : l * BP + b) * NH + h) * 4096 + (v0 + li) * 64 + 4 * g;
            if (smp) {
#pragma unroll
                for (int t = 0; t < 4; ++t) St[t] = *(const f32x4*)(p.state_wkv + sbase + 16 * t); }
            else {
#pragma unroll
                for (int t = 0; t < 4; ++t) St[t] = (f32x4){0.f, 0.f, 0.f, 0.f}; }
            SC_BAR(); SC_BAR();
            for (int R = 0; R < nR; ++R) {
                { LAS unsigned char* tsl = lds + ((R & 1) * 4 + wave) * SC_SLOT;
                {
                    float Z[16]; int lic = li; asm volatile("" : "+v"(lic));
                    const LAS f32x4* gabp = (const LAS f32x4*)(tsl + SC_GAB);
                    f32x4 n0 = gabp[4], n1 = gabp[5], n2 = gabp[6], n3 = gabp[7]; float nrhs = (g & 1) ? *(const LAS float*)(tsl + SC_GAK + (16 + lic) * 4) : (1 == lic ? 1.0f : 0.f);
                    Z[0] = (g & 1) ? *(const LAS float*)(tsl + SC_GAK + lic * 4) : (0 == lic ? 1.0f : 0.f);
                    *(LAS bf16*)(tsl + SC_TT + ((0 * 4 + (li >> 2)) * 8 + (g & 1) * 4 + (li & 3)) * 2) = (bf16)cvtpk(Z[0], 0.f);
#pragma unroll
                    for (int i = 1; i < 16; ++i) {
                        const f32x4 g0 = n0, g1 = n1, g2 = n2, g3 = n3; const float rhs = nrhs;
                        if (i + 1 < 16) { n0 = gabp[(i + 1) * 4]; n1 = gabp[(i + 1) * 4 + 1]; n2 = gabp[(i + 1) * 4 + 2]; n3 = gabp[(i + 1) * 4 + 3];
                            nrhs = (g & 1) ? *(const LAS float*)(tsl + SC_GAK + ((i + 1) * 16 + lic) * 4) : ((i + 1) == lic ? 1.0f : 0.f); }
                        const float gr[16] = {g0.x, g0.y, g0.z, g0.w, g1.x, g1.y, g1.z, g1.w, g2.x, g2.y, g2.z, g2.w, g3.x, g3.y, g3.z, g3.w};
                        float acc0 = rhs, acc1 = 0.f;
#pragma unroll
                        for (int j = 0; j < 16; ++j) if (j < i) { if (j & 1) acc1 += gr[j] * Z[j]; else acc0 += gr[j] * Z[j]; }
                        const float acc = acc0 + acc1;
                        Z[i] = acc;
                        *(LAS bf16*)(tsl + SC_TT + ((i * 4 + (li >> 2)) * 8 + (g & 1) * 4 + (li & 3)) * 2) = (bf16)cvtpk(acc, 0.f);
                    }
                }
                }
                SC_BAR();
#pragma unroll 1
                for (int q = 0; q < 4; ++q) {
                    const LAS unsigned char* slot = lds + ((R & 1) * 4 + q) * SC_SLOT; const int c = 4 * R + q;
                    const int o0 = ((li * 2 + 0) * 4 + g) * 16, o1 = ((li * 2 + 1) * 4 + g) * 16;
                    const s16x8 aA0 = *(const LAS s16x8*)(slot + SC_AT + o0), aA1 = *(const LAS s16x8*)(slot + SC_AT + o1), aR0 = *(const LAS s16x8*)(slot + SC_RT + o0), aR1 = *(const LAS s16x8*)(slot + SC_RT + o1);
                    const s16x8 aT = *(const LAS s16x8*)(slot + SC_TT + (li * 4 + g) * 16), aG = *(const LAS s16x8*)(slot + SC_GG + (li * 4 + g) * 16);
                    const v2u vq = *(const LAS v2u*)(slot + SC_VT + vt_off(v0 + li, g));
                    const s16x8 bS0 = mk8(cvtpk(St[0][0], St[0][1]), cvtpk(St[0][2], St[0][3]), cvtpk(St[1][0], St[1][1]), cvtpk(St[1][2], St[1][3]));
                    const s16x8 bS1 = mk8(cvtpk(St[2][0], St[2][1]), cvtpk(St[2][2], St[2][3]), cvtpk(St[3][0], St[3][1]), cvtpk(St[3][2], St[3][3]));
                    const f32x4 z4 = (f32x4){0.f, 0.f, 0.f, 0.f};
                    f32x4 Xa = __builtin_amdgcn_mfma_f32_16x16x32_bf16(aA0, bS0, z4, 0, 0, 0); Xa = __builtin_amdgcn_mfma_f32_16x16x32_bf16(aA1, bS1, Xa, 0, 0, 0);
                    f32x4 Xr = __builtin_amdgcn_mfma_f32_16x16x32_bf16(aR0, bS0, z4, 0, 0, 0); Xr = __builtin_amdgcn_mfma_f32_16x16x32_bf16(aR1, bS1, Xr, 0, 0, 0);
                    const s16x8 bXV = mk8(cvtpk(Xa[0], Xa[1]), cvtpk(Xa[2], Xa[3]), vq.x, vq.y);
                    const f32x4 Uu = __builtin_amdgcn_mfma_f32_16x16x32_bf16(aT, bXV, z4, 0, 0, 0);
                    const s16x8 bUV = mk8(cvtpk(Uu[0], Uu[1]), cvtpk(Uu[2], Uu[3]), vq.x, vq.y);
                    const f32x4 Yy = __builtin_amdgcn_mfma_f32_16x16x32_bf16(aG, bUV, Xr, 0, 0, 0);
#pragma unroll
                    for (int t = 0; t < 4; ++t) { const s16x8 aBK = *(const LAS s16x8*)(slot + SC_BK + bk_off(16 * t + li, g)); const f32x4 pc = *(const LAS f32x4*)(slot + SC_PC + (16 * t + 4 * g) * 4);
                        St[t] = __builtin_amdgcn_mfma_f32_16x16x32_bf16(aBK, bUV, pc * St[t], 0, 0, 0); }
                    int liq = lane; asm volatile("" : "+v"(liq));
                    float* yo = Y + (size_t)(m0 + 16 * c + 4 * (liq >> 4)) * 512 + h * 64 + v0 + (liq & 15);
                    yo[0] = Yy[0]; yo[512] = Yy[1]; yo[1024] = Yy[2]; yo[1536] = Yy[3];
                }
                SC_BAR();
            }
            float* so = p.out + (smp ? O_WKVS : O_WKVP) + sbase;
#pragma unroll
            for (int t = 0; t < 4; ++t) *(f32x4*)(so + 16 * t) = St[t];
        }
    }
}

__device__ __forceinline__ void small_tile(LAS unsigned char* lds, const bf16* A, const bf16* Bt, int K, int arow0, int brow0, float* res) {
    int tid_ = threadIdx.x; asm volatile("" : "+v"(tid_)); const int tid = tid_, lane = tid & 63, wave = __builtin_amdgcn_readfirstlane(tid >> 6), fr = lane & 15, fq = lane >> 4;
    const int ksl = K >> 3, kbeg = wave * ksl;
    pg8::f32x4 acc[4][4];
#pragma unroll
    for (int i = 0; i < 4; ++i)
#pragma unroll
        for (int j = 0; j < 4; ++j) acc[i][j] = (pg8::f32x4){0.f, 0.f, 0.f, 0.f};
    const bf16* ap = A + (size_t)(arow0 + fr) * K + kbeg + 8 * fq; const bf16* bp = Bt + (size_t)(brow0 + fr) * K + kbeg + 8 * fq;
    pg8::bf16x8 af[4], bfr[4], af2[4], bf2[4];
#pragma unroll
    for (int i = 0; i < 4; ++i) { af[i] = *(const pg8::bf16x8*)(ap + (size_t)(16 * i) * K); bfr[i] = *(const pg8::bf16x8*)(bp + (size_t)(16 * i) * K); }
    for (int k = 0; k < ksl; k += 64) {
        const int k1 = k + 32, k2 = (k + 64 < ksl) ? k + 64 : k;
        const int k1c = (k1 < ksl) ? k1 : k;
#pragma unroll
        for (int i = 0; i < 4; ++i) { af2[i] = *(const pg8::bf16x8*)(ap + (size_t)(16 * i) * K + k1c); bf2[i] = *(const pg8::bf16x8*)(bp + (size_t)(16 * i) * K + k1c); }
#pragma unroll
        for (int i = 0; i < 4; ++i)
#pragma unroll
            for (int j = 0; j < 4; ++j) acc[i][j] = __builtin_amdgcn_mfma_f32_16x16x32_bf16(bfr[j], af[i], acc[i][j], 0, 0, 0);
#pragma unroll
        for (int i = 0; i < 4; ++i) { af[i] = *(const pg8::bf16x8*)(ap + (size_t)(16 * i) * K + k2); bfr[i] = *(const pg8::bf16x8*)(bp + (size_t)(16 * i) * K + k2); }
        if (k1 < ksl) {
#pragma unroll
            for (int i = 0; i < 4; ++i)
#pragma unroll
                for (int j = 0; j < 4; ++j) acc[i][j] = __builtin_amdgcn_mfma_f32_16x16x32_bf16(bf2[j], af2[i], acc[i][j], 0, 0, 0);
        }
    }
    LAS float* part = (LAS float*)lds;
#pragma unroll
    for (int i = 0; i < 4; ++i)
#pragma unroll
        for (int j = 0; j < 4; ++j) *(LAS pg8::f32x4*)(part + ((wave * 64 + 16 * i + fr) * 64 + 16 * j + 4 * fq)) = acc[i][j];
    __syncthreads();
    const int m = tid >> 3, n0 = (tid & 7) * 8;
    pg8::f32x4 s0 = (pg8::f32x4){0.f, 0.f, 0.f, 0.f}, s1 = s0;
#pragma unroll
    for (int w = 0; w < 8; ++w) { s0 += *(const LAS pg8::f32x4*)(part + ((w * 64 + m) * 64 + n0)); s1 += *(const LAS pg8::f32x4*)(part + ((w * 64 + m) * 64 + n0 + 4)); }
    res[0] = s0[0]; res[1] = s0[1]; res[2] = s0[2]; res[3] = s0[3]; res[4] = s1[0]; res[5] = s1[1]; res[6] = s1[2]; res[7] = s1[3];
    __syncthreads();
}
__device__ __forceinline__ void small_gemm(LAS unsigned char* lds, const bf16* A, const bf16* Bt, int K, int N, int mode, bf16* O, int ldc, float* F, const float* bw, const float* ba, unsigned* ctr) {
    int tid_ = threadIdx.x; asm volatile("" : "+v"(tid_)); const int tid = tid_;
    const int ntn = N / 64, ntiles = (NS / 64) * ntn, m = tid >> 3, n0 = (tid & 7) * 8;
    volatile LAS unsigned* tq = (volatile LAS unsigned*)(lds + PTAB_OFF + 416);
    for (;;) {
        if (tid == 0) tq[0] = __hip_atomic_fetch_add(ctr, 1u, __ATOMIC_RELAXED, __HIP_MEMORY_SCOPE_AGENT);
        __syncthreads();
        const int t = (int)tq[0];
        __syncthreads();
        if (t >= ntiles) break;
        const int tm = t / ntn, tn = t % ntn, row = NP + 64 * tm + m, c0 = 64 * tn;
        float r[8];
        if (mode == 1) {
            float g[8]; const int br = (c0 >> 7) * 256 + (c0 & 127);
            small_tile(lds, A, Bt, K, NP + 64 * tm, br, g);
            small_tile(lds, A, Bt, K, NP + 64 * tm, br + 128, r);
#pragma unroll
            for (int i = 0; i < 8; ++i) r[i] = g[i] * sigm(g[i]) * r[i];
            *(v4u*)(O + (size_t)row * ldc + c0 + n0) = pack8(r);
        } else {
            small_tile(lds, A, Bt, K, NP + 64 * tm, c0, r);
            if (mode == 2 && c0 < 512) {
#pragma unroll
                for (int i = 0; i < 8; ++i) r[i] = 0.6065306597f * sigm(r[i] + bw[c0 + n0 + i]);
                float* o = F + (size_t)row * 512 + c0 + n0; *(f32x4*)o = (f32x4){r[0], r[1], r[2], r[3]}; *(f32x4*)(o + 4) = (f32x4){r[4], r[5], r[6], r[7]}; }
            else { if (mode == 2 && c0 < 1024) {
#pragma unroll
                    for (int i = 0; i < 8; ++i) r[i] = sigm(r[i] + ba[c0 - 512 + n0 + i]); }
                *(v4u*)(O + (size_t)row * ldc + (mode == 2 ? c0 - 512 : c0) + n0) = pack8(r); }
        }
    }
}


constexpr size_t WS_BAR = 4 * MiB + 512 * 1024;
static_assert(WS_RK + (size_t)NTOK * NH * 4 <= WS_BAR && XCD_BAR_WORDS * 4 <= 16384 && WS_BAR + 16384 + 1024 <= WS_WIN, "barrier words + the ten sample-tile counters (one 64-B line per GEMM phase)");
__device__ __forceinline__ void grid_bar(LAS unsigned char* lds) {
    int i34 = 34; asm volatile("" : "+s"(i34));
    XcdBarrier b; b.bar = (unsigned*)((__attribute__((address_space(1))) unsigned char*)ldp_(lds, i34) + WS_BAR); b.x = xb_xcc_id(); b.st = (volatile LAS unsigned*)(lds + PTAB_OFF + 400);
    xcd_barrier(b);
}
#define GSYNC() grid_bar(lds)
#define CONV_CTR(l_) ((unsigned*)((__attribute__((address_space(1))) unsigned char*)ldp_(lds, 34) + WS_BAR + 16384) + (10 + (l_)) * 16)
__global__ void __launch_bounds__(NTHR, 2) hymba_fwd(Params p) {
    extern __shared__ __attribute__((aligned(16))) unsigned char lds_raw[];
    cg::grid_group grid = cg::this_grid();
    LAS unsigned char* lds = (LAS unsigned char*)lds_raw;
    if (threadIdx.x == 0) { store_params(p, lds); ((volatile LAS unsigned*)(lds + PTAB_OFF + 400))[0] = 0u; ((volatile LAS unsigned*)(lds + PTAB_OFF + 400))[1] = 0u; }
    __syncthreads();
    (void)xcd_barrier_post((unsigned*)(p.ws + WS_BAR), (volatile LAS unsigned*)(lds + PTAB_OFF + 400));
    if ((int)gridDim.x >= 192) {
        if ((int)blockIdx.x < (int)gridDim.x - 96) phase_weights(lds, 0, 0, (int)gridDim.x - 96); else phase_mod(lds, (int)gridDim.x - 96);
    } else { phase_weights(lds, 0, 0, (int)gridDim.x); __syncthreads(); phase_mod(lds, 0); }
    grid.sync();
    phase_rows<0>(lds, 0);
    GSYNC();
    for (int st = 0; st < 10; ++st) {
        const int l = st / 5, k = st % 5;
        {
            pg8::Gemm g; pg8::EpiMulti E; int N;
            int i34 = 34; asm volatile("" : "+s"(i34));
            unsigned char* ws = (unsigned char*)(__attribute__((address_space(1))) unsigned char*)ldp_(lds, i34);
            bf16* Ub = (bf16*)(ws + WS_U); bf16* Hb = (bf16*)(ws + WS_H); bf16* TMPb = (bf16*)(ws + WS_TMP);
            if (k == 0)      { N = DIN;     g.A = Hb; g.Bt = (const bf16*)(ws + WS_WIN) + (size_t)l * DIN * DM; g.K = DM; E.mode = 0; E.O = Ub; E.ldc = DIN; E.F = nullptr; E.bw = nullptr; E.ba = nullptr; }
            else if (k == 1) { N = 1536;    g.A = (const bf16*)(ws + WS_LA); g.Bt = (const bf16*)(ws + WS_WLR) + (size_t)l * 1536 * 256; g.K = 256; E.mode = 2; E.O = (bf16*)(ws + WS_AG); E.ldc = 1024; E.F = (float*)(ws + WS_DEC); E.bw = (const float*)(__attribute__((address_space(1))) const float*)ldp_(lds, 19) + l * DRW; E.ba = (const float*)(__attribute__((address_space(1))) const float*)ldp_(lds, 21) + l * DRW; }
            else if (k == 2) { N = DM;      g.A = Hb; g.Bt = (const bf16*)(ws + WS_WOUT) + (size_t)l * DM * DM; g.K = DM; E.mode = 0; E.O = TMPb; E.ldc = DM; E.F = nullptr; E.bw = nullptr; E.ba = nullptr; }
            else if (k == 3) { N = 2 * DFF; g.A = Hb; g.Bt = (const bf16*)(ws + WS_WGU) + (size_t)l * 2 * DFF * DM; g.K = DM; E.mode = 1; E.O = Ub; E.ldc = DFF; E.F = nullptr; E.bw = nullptr; E.ba = nullptr; }
            else             { N = DM;      g.A = Ub; g.Bt = (const bf16*)(ws + WS_WDN) + (size_t)l * DM * DFF; g.K = DFF; E.mode = 0; E.O = TMPb; E.ldc = DM; E.F = nullptr; E.bw = nullptr; E.ba = nullptr; }
            g.M = NP; g.N = N;
            pg8::StaticOrder S; S.init(NP, N, (int)gridDim.x, (int)blockIdx.x);
            pg8::gemm_phase<pg8::EpiMulti, pg8::StaticOrder, true, true>(lds, g, S, E);
            small_gemm(lds, g.A, g.Bt, g.K, k == 3 ? DFF : N, E.mode, E.O, E.ldc, E.F, E.bw, E.ba, (unsigned*)(ws + WS_BAR + 16384) + st * 16);
        }
        GSYNC();
        if (k == 0) { phase_prepA(lds, l); GSYNC(); }
        else if (k == 1) { phase_scan2(lds, l); if ((int)gridDim.x >= 256) { if (blockIdx.x >= 128) { __syncthreads(); phase_conv(lds, l, CONV_CTR(l)); if (l == 0) { __syncthreads(); phase_weights(lds, 1, 128, (int)gridDim.x - 128); } } } else { __syncthreads(); phase_conv(lds, l, CONV_CTR(l)); if (l == 0) { __syncthreads(); phase_weights(lds, 1, 0, (int)gridDim.x); } } GSYNC(); phase_post(lds, l); GSYNC(); }
        else if (k == 2) { phase_rows<1>(lds, l); GSYNC(); }
        else if (k == 4) { phase_rows<2>(lds, l); if (l == 0) GSYNC(); }
    }
}

extern "C" void kernel_launch(void* const* d_in, const int* in_sizes, int n_in, void* d_out, int out_size, void* d_ws, size_t ws_size, hipStream_t stream) {
    static int grid = 0;
    if (grid == 0) {
        if (n_in != 33 || ws_size < WS_END) { fprintf(stderr, "kernel_launch: unexpected n_in %d / ws_size %zu (need %zu)\n", n_in, ws_size, (size_t)WS_END); grid = -1; return; }
        int dev = 0, cus = 0, per_cu = 0;
        (void)hipGetDevice(&dev); (void)hipDeviceGetAttribute(&cus, hipDeviceAttributeMultiprocessorCount, dev);
        if (hipFuncSetAttribute((const void*)hymba_fwd, hipFuncAttributeMaxDynamicSharedMemorySize, LDS_BYTES) != hipSuccess) { fprintf(stderr, "kernel_launch: hipFuncSetAttribute failed\n"); grid = -1; return; }
        if (hipOccupancyMaxActiveBlocksPerMultiprocessor(&per_cu, (const void*)hymba_fwd, NTHR, LDS_BYTES) != hipSuccess || per_cu < 1) { fprintf(stderr, "kernel_launch: occupancy query gave %d\n", per_cu); per_cu = 1; }
        (void)hipGetLastError();
        grid = cus * per_cu;
        fprintf(stderr, "kernel_launch: grid %d (cus %d x %d)\n", grid, cus, per_cu);
    }
    if (grid < 0) return;
    (void)hipMemsetAsync((char*)d_ws + WS_BAR, 0, 16384 + 1024, stream);
    Params p{};
    const float** pp = (const float**)&p;
    for (int i = 0; i < 33; ++i) pp[i] = (const float*)d_in[i];
    p.out = (float*)d_out; p.ws = (unsigned char*)d_ws;
    void* args[] = {&p};
    hipError_t e = hipLaunchCooperativeKernel((const void*)hymba_fwd, dim3(grid), dim3(NTHR), args, LDS_BYTES, stream);
    if (e != hipSuccess) fprintf(stderr, "kernel_launch: cooperative launch failed: %s (grid %d)\n", hipGetErrorString(e), grid);
}
```

```cpp
#include <hip/hip_runtime.h>
#include <hip/hip_cooperative_groups.h>
#include <cstdio>
#include <cstdint>
namespace cg = cooperative_groups;
namespace pg8 {
#define PG8_LAS __attribute__((address_space(3)))
typedef unsigned short bf16_t;
typedef short bf16x8 __attribute__((ext_vector_type(8)));
typedef float f32x4 __attribute__((ext_vector_type(4)));
typedef unsigned u32x4 __attribute__((ext_vector_type(4)));
constexpr int BM = 256, BK = 64, HALF = 128, HTB = HALF * BK * 2  , STAGE_BYTES = 8 * HTB, NXCD = 8, WGM = 8;

__host__ __device__ __forceinline__ int lds_byte(int r, int c) { const int st = (r >> 4) * 2 + (c >> 5), rr = r & 15, cc = c & 31, ob = rr * 64 + cc * 2; return st * 1024 + (ob ^ (((ob >> 9) & 1) << 5)); }
__host__ __device__ __forceinline__ void stage_rc(int b, int& R, int& C) { const int st = b / 1024, sb = b % 1024, swz = sb ^ (((sb >> 9) & 1) << 5); R = (st >> 1) * 16 + swz / 64; C = (st & 1) * 32 + (swz % 64) / 2; }
__host__ __device__ __forceinline__ int perm32(int rho) { const int n = rho >> 4, i = rho & 15; return 8 * (i >> 2) + 4 * n + (i & 3); }

struct Unit { int pm, pn; };
struct Gemm { const bf16_t* A; const bf16_t* Bt; int M, N, K; };

struct StaticOrder {
    int nM, nN, nwg, G, c;
    __host__ __device__ void init(int M, int N, int G_, int c_) { nM = M / BM; nN = N / BM; nwg = nM * nN; G = G_; c = c_; }
    __host__ __device__ bool next(int i, Unit& u) const {
        const long L = (long)i * G + c; if (L >= nwg) return false;
        int wgid = (int)L; { const int q = nwg / NXCD, r = nwg % NXCD, xcd = wgid % NXCD, off = wgid / NXCD; wgid = (xcd < r ? xcd * (q + 1) : r * (q + 1) + (xcd - r) * q) + off; }
        const int nig = WGM * nN, gid = wgid / nig, fm = gid * WGM, gsz = (nM - fm) < WGM ? (nM - fm) : WGM;
        u.pm = fm + ((wgid % nig) % gsz); u.pn = (wgid % nig) / gsz; return true;
    }
    __device__ __forceinline__ void a_ready(const Unit&) const {}
    __device__ __forceinline__ void done(const Unit&) const {}
};

__device__ __forceinline__ unsigned cvt_pk_bf16(float lo, float hi) { unsigned r; asm volatile("v_cvt_pk_bf16_f32 %0, %1, %2" : "=v"(r) : "v"(lo), "v"(hi)); return r; }
__device__ __forceinline__ float fsigmoid(float x) { return __builtin_amdgcn_rcpf(1.0f + __expf(-x)); }
struct EpiMulti {
    static constexpr bool PERM = true, AFTER_DRAIN = false;
    int mode; bf16_t* O; int ldc; float* F; const float* bw; const float* ba;
    __device__ __forceinline__ void operator()(const f32x4 (&acc)[2][2][4][2], const Unit& u, int wr, int wc, int fr, int fq) const {
        const int row0 = u.pm * BM + wr * 64 + fr;
        if (mode == 1) {
            const int col0 = u.pn * HALF + wc * 32 + 8 * fq;
#pragma unroll
            for (int ai = 0; ai < 2; ++ai)
#pragma unroll
                for (int m = 0; m < 4; ++m) { bf16_t* rowp = O + (size_t)(row0 + ai * HALF + m * 16) * ldc + col0;
                    float f[8];
#pragma unroll
                    for (int n = 0; n < 2; ++n)
#pragma unroll
                        for (int i = 0; i < 4; ++i) { const float g = acc[ai][0][m][n][i], up = acc[ai][1][m][n][i]; f[n * 4 + i] = g * fsigmoid(g) * up; }
                    u32x4 w; w.x = cvt_pk_bf16(f[0], f[1]); w.y = cvt_pk_bf16(f[2], f[3]); w.z = cvt_pk_bf16(f[4], f[5]); w.w = cvt_pk_bf16(f[6], f[7]);
                    *(u32x4*)rowp = w; }
        } else if (mode == 2 && u.pn < 2) {
            const int col0 = u.pn * BM + wc * 32 + 8 * fq;
#pragma unroll
            for (int ai = 0; ai < 2; ++ai)
#pragma unroll
                for (int m = 0; m < 4; ++m) { float* rowp = F + (size_t)(row0 + ai * HALF + m * 16) * 512 + col0;
#pragma unroll
                    for (int bj = 0; bj < 2; ++bj) { const f32x4 b0 = *(const f32x4*)(bw + col0 + bj * HALF), b1 = *(const f32x4*)(bw + col0 + bj * HALF + 4); f32x4 o0, o1;
#pragma unroll
                        for (int i = 0; i < 4; ++i) { o0[i] = 0.6065306597f * fsigmoid(acc[ai][bj][m][0][i] + b0[i]); o1[i] = 0.6065306597f * fsigmoid(acc[ai][bj][m][1][i] + b1[i]); }
                        *(f32x4*)(rowp + bj * HALF) = o0; *(f32x4*)(rowp + bj * HALF + 4) = o1; } }
        } else {
            const int col0 = (mode == 2 ? (u.pn - 2) : u.pn) * BM + wc * 32 + 8 * fq;
#pragma unroll
            for (int ai = 0; ai < 2; ++ai)
#pragma unroll
                for (int m = 0; m < 4; ++m) { bf16_t* rowp = O + (size_t)(row0 + ai * HALF + m * 16) * ldc + col0;
#pragma unroll
                    for (int bj = 0; bj < 2; ++bj) { f32x4 v0 = acc[ai][bj][m][0], v1 = acc[ai][bj][m][1];
                        if (mode == 2 && u.pn < 4) { const f32x4 b0 = *(const f32x4*)(ba + col0 + bj * HALF), b1 = *(const f32x4*)(ba + col0 + bj * HALF + 4);
#pragma unroll
                            for (int i = 0; i < 4; ++i) { v0[i] = fsigmoid(v0[i] + b0[i]); v1[i] = fsigmoid(v1[i] + b1[i]); } }
                        u32x4 w; w.x = cvt_pk_bf16(v0[0], v0[1]); w.y = cvt_pk_bf16(v0[2], v0[3]); w.z = cvt_pk_bf16(v1[0], v1[1]); w.w = cvt_pk_bf16(v1[2], v1[3]);
                        *(u32x4*)(rowp + bj * HALF) = w; } }
        }
    }
};

template <class Epi, class Sched, bool ALIGN_EPI = false, bool SP2 = false>
__device__ __forceinline__ void gemm_phase(PG8_LAS unsigned char* lds, const Gemm g, const Sched& S, const Epi& E) {
    int tid_l = threadIdx.x; asm volatile("" : "+v"(tid_l));
    const int tid = tid_l, wid = __builtin_amdgcn_readfirstlane(tid >> 6), lane = tid & 63, wr = wid >> 2, wc = wid & 3, fr = lane & 15, fq = lane >> 4;
    const int K = g.K, nt = K / BK;
    unsigned voffA[2], voffB[2];
#pragma unroll
    for (int i = 0; i < 2; ++i) { int R, C; stage_rc(tid * 16 + i * 8192, R, C); const int Rb = Epi::PERM ? ((R & ~31) + perm32(R & 31)) : R;
        voffA[i] = (unsigned)(R * K + C) * 2u; voffB[i] = (unsigned)(Rb * K + C) * 2u; }
    const size_t kstep = (size_t)(BK * 2);
    const size_t hstep = (size_t)HALF * K * 2;
    const size_t tstep = 2 * hstep;
    const unsigned ldsw = (unsigned)wid * 1024u;
    const int aoff = lds_byte(wr * 64 + fr, fq * 8), boff = lds_byte(wc * 32 + fr, fq * 8);
#define PG8_SA(b, h) (((b) * 2 + (h)) * HTB)
#define PG8_SB(b, h) ((4 + (b) * 2 + (h)) * HTB)
#define PG8_STAGE(bufoff, gbase, voff) do { _Pragma("unroll") for (int _i = 0; _i < 2; ++_i) \
        __builtin_amdgcn_global_load_lds((const unsigned*)((const char*)(gbase) + (voff)[_i]), (PG8_LAS unsigned*)(lds + (bufoff) + ldsw + _i * 8192), 16, 0, 0); } while (0)
#define PG8_LDA(dst, b, h) do { _Pragma("unroll") for (int m = 0; m < 4; ++m) _Pragma("unroll") for (int k = 0; k < 2; ++k) dst[m][k] = *(const PG8_LAS bf16x8*)(lds + PG8_SA(b, h) + aoff + m * 2048 + k * 1024); } while (0)
#define PG8_LDB(dst, b, h) do { _Pragma("unroll") for (int n = 0; n < 2; ++n) _Pragma("unroll") for (int k = 0; k < 2; ++k) dst[n][k] = *(const PG8_LAS bf16x8*)(lds + PG8_SB(b, h) + boff + n * 2048 + k * 1024); } while (0)
#define PG8_MMA(ai, bj, At, Bt) do { __builtin_amdgcn_s_setprio(1); _Pragma("unroll") for (int m = 0; m < 4; ++m) _Pragma("unroll") for (int n = 0; n < 2; ++n) _Pragma("unroll") for (int k = 0; k < 2; ++k) \
        acc[ai][bj][m][n] = __builtin_amdgcn_mfma_f32_16x16x32_bf16(Bt[n][k], At[m][k], acc[ai][bj][m][n], 0, 0, 0); __builtin_amdgcn_s_setprio(0); } while (0)
#define PG8_WAIT_V(n) asm volatile("s_waitcnt vmcnt(" #n ")" ::: "memory")
#define PG8_WAIT_L(n) asm volatile("s_waitcnt lgkmcnt(" #n ")" ::: "memory")
#define PG8_BAR __builtin_amdgcn_s_barrier()
#define PG8_SCHED __builtin_amdgcn_sched_barrier(0)
    Unit cur, nxt; int ui = 0;
    if (!S.next(0, cur)) return;
    f32x4 acc[2][2][4][2];
#pragma unroll
    for (int a = 0; a < 2; ++a)
#pragma unroll
        for (int b = 0; b < 2; ++b)
#pragma unroll
            for (int m = 0; m < 4; ++m)
#pragma unroll
                for (int n = 0; n < 2; ++n) acc[a][b][m][n] = (f32x4){0.f, 0.f, 0.f, 0.f};
    bf16x8 At[4][2], B0[2][2], B1[2][2];
    const char* cA = (const char*)g.A + (size_t)cur.pm * tstep; const char* cB = (const char*)g.Bt + (size_t)cur.pn * tstep;
    S.a_ready(cur);
    if constexpr (SP2) {
        PG8_STAGE(PG8_SB(0, 0), cB, voffB); PG8_STAGE(PG8_SB(0, 1), cB + hstep, voffB); PG8_STAGE(PG8_SA(0, 0), cA, voffA); PG8_STAGE(PG8_SA(0, 1), cA + hstep, voffA);
        if (wr == 1) PG8_BAR;
        PG8_WAIT_V(2); PG8_BAR;
        PG8_STAGE(PG8_SB(1, 0), cB + kstep, voffB); PG8_STAGE(PG8_SA(1, 0), cA + kstep, voffA); PG8_STAGE(PG8_SB(1, 1), cB + hstep + kstep, voffB);
        PG8_WAIT_V(6); PG8_BAR;
    } else {
        PG8_STAGE(PG8_SB(0, 0), cB, voffB); PG8_STAGE(PG8_SA(0, 0), cA, voffA); PG8_STAGE(PG8_SB(0, 1), cB + hstep, voffB); PG8_STAGE(PG8_SA(0, 1), cA + hstep, voffA);
        if (wr == 1) PG8_BAR;
        PG8_WAIT_V(4); PG8_BAR;
        PG8_STAGE(PG8_SB(1, 0), cB + kstep, voffB); PG8_STAGE(PG8_SA(1, 0), cA + kstep, voffA); PG8_STAGE(PG8_SB(1, 1), cB + hstep + kstep, voffB);
        PG8_WAIT_V(6); PG8_BAR;
    }
    for (;;) {
        const bool has_next = S.next(ui + 1, nxt);
        const char* nA = has_next ? (const char*)g.A + (size_t)nxt.pm * tstep : cA; const char* nB = has_next ? (const char*)g.Bt + (size_t)nxt.pn * tstep : cB;
        for (int t = 0; t < nt; t += 2) {
            const bool last = (t == nt - 2);
            const char* a1 = cA + (size_t)(t + 1) * kstep;
            const char* a2 = last ? nA : cA + (size_t)(t + 2) * kstep; const char* b2 = last ? nB : cB + (size_t)(t + 2) * kstep;
            const char* a3 = a2 + kstep; const char* b3 = b2 + kstep;
            if (last && has_next) S.a_ready(nxt);
            if constexpr (SP2) {
            PG8_LDB(B0, 0, 0); PG8_LDB(B1, 0, 1); PG8_SCHED; PG8_LDA(At, 0, 0); PG8_STAGE(PG8_SA(1, 1), a1 + hstep, voffA);
            PG8_WAIT_V(8); PG8_WAIT_L(0); PG8_BAR; PG8_MMA(0, 0, At, B0); PG8_MMA(0, 1, At, B1); PG8_BAR; PG8_SCHED;
            PG8_LDA(At, 0, 1); PG8_STAGE(PG8_SB(0, 0), b2, voffB); PG8_STAGE(PG8_SB(0, 1), b2 + hstep, voffB); PG8_STAGE(PG8_SA(0, 0), a2, voffA);
            PG8_WAIT_V(8); PG8_WAIT_L(0); PG8_BAR; PG8_MMA(1, 0, At, B0); PG8_MMA(1, 1, At, B1); PG8_BAR; PG8_SCHED;
            PG8_LDB(B0, 1, 0); PG8_LDB(B1, 1, 1); PG8_SCHED; PG8_LDA(At, 1, 0); PG8_STAGE(PG8_SA(0, 1), a2 + hstep, voffA);
            PG8_WAIT_V(8); PG8_WAIT_L(0); PG8_BAR; PG8_MMA(0, 0, At, B0); PG8_MMA(0, 1, At, B1); PG8_BAR; PG8_SCHED;
            PG8_LDA(At, 1, 1); PG8_STAGE(PG8_SB(1, 0), b3, voffB); PG8_STAGE(PG8_SB(1, 1), b3 + hstep, voffB); PG8_STAGE(PG8_SA(1, 0), a3, voffA);
            PG8_WAIT_V(8); PG8_WAIT_L(0); PG8_BAR; PG8_MMA(1, 0, At, B0); PG8_MMA(1, 1, At, B1); PG8_BAR; PG8_SCHED;
            } else {
            PG8_LDB(B0, 0, 0); PG8_SCHED; PG8_LDA(At, 0, 0); PG8_STAGE(PG8_SA(1, 1), a1 + hstep, voffA);
            PG8_WAIT_L(8); PG8_BAR; PG8_WAIT_L(0); PG8_MMA(0, 0, At, B0); PG8_BAR; PG8_SCHED;
            PG8_LDB(B1, 0, 1); PG8_STAGE(PG8_SB(0, 0), b2, voffB);
            PG8_BAR; PG8_WAIT_L(0); PG8_MMA(0, 1, At, B1); PG8_BAR;
            PG8_LDA(At, 0, 1); PG8_STAGE(PG8_SA(0, 0), a2, voffA);
            PG8_BAR; PG8_WAIT_L(0); PG8_MMA(1, 0, At, B0); PG8_BAR; PG8_SCHED;
            PG8_STAGE(PG8_SB(0, 1), b2 + hstep, voffB);
            PG8_WAIT_V(6); PG8_BAR; PG8_MMA(1, 1, At, B1); PG8_BAR;
            PG8_LDB(B0, 1, 0); PG8_SCHED; PG8_LDA(At, 1, 0); PG8_STAGE(PG8_SA(0, 1), a2 + hstep, voffA);
            PG8_WAIT_L(8); PG8_BAR; PG8_WAIT_L(0); PG8_MMA(0, 0, At, B0); PG8_BAR; PG8_SCHED;
            PG8_LDB(B1, 1, 1); PG8_STAGE(PG8_SB(1, 0), b3, voffB);
            PG8_BAR; PG8_WAIT_L(0); PG8_MMA(0, 1, At, B1); PG8_BAR;
            PG8_LDA(At, 1, 1); PG8_STAGE(PG8_SA(1, 0), a3, voffA);
            PG8_BAR; PG8_WAIT_L(0); PG8_MMA(1, 0, At, B0); PG8_BAR; PG8_SCHED;
            PG8_STAGE(PG8_SB(1, 1), b3 + hstep, voffB);
            PG8_WAIT_V(6); PG8_BAR; PG8_MMA(1, 1, At, B1); PG8_BAR;
            }
        }
        if constexpr (ALIGN_EPI) { if (wr == 0) PG8_BAR; }
        if constexpr (!Epi::AFTER_DRAIN) { E(acc, cur, wr, wc, fr, fq); S.done(cur); }
        if (!has_next) break;
#pragma unroll
        for (int a = 0; a < 2; ++a)
#pragma unroll
            for (int b = 0; b < 2; ++b)
#pragma unroll
                for (int m = 0; m < 4; ++m)
#pragma unroll
                    for (int n = 0; n < 2; ++n) acc[a][b][m][n] = (f32x4){0.f, 0.f, 0.f, 0.f};
        cur = nxt; cA = nA; cB = nB; ++ui;
        if constexpr (ALIGN_EPI) { if (wr == 1) PG8_BAR; }
    }
    PG8_WAIT_V(0);
    if constexpr (!ALIGN_EPI) { if (wr == 0) PG8_BAR; }
    PG8_BAR;
    if constexpr (Epi::AFTER_DRAIN) { E.fused(acc, cur, wr, wc, fr, fq, lds, wid, lane); S.done(cur); }
#undef PG8_SA
#undef PG8_SB
#undef PG8_STAGE
#undef PG8_LDA
#undef PG8_LDB
#undef PG8_MMA
#undef PG8_WAIT_V
#undef PG8_WAIT_L
#undef PG8_BAR
#undef PG8_SCHED
}
}

constexpr int NWAVES = 8, NTHR = 512;
constexpr int DM = 1024, NP = 65536, NS = 512, NTOK = NP + NS, TP = 4096, TS = 64, BP = 16, BS = 8, NB = BP + BS;
constexpr int DIN = 2816, DFF = 2816, DSH = 1792, DCV = 512, DRW = 512, CBUF = 30, CW = 31, NH = 8;
constexpr int LDS_BYTES = 147456;
constexpr size_t O_Y = 0, O_CONVP = 67633152, O_SHIFTP = 68124672, O_WKVP = 68182016, O_CONVS = 69230592, O_SHIFTS = 69476352, O_WKVS = 69505024;
constexpr size_t MiB = 1u << 20;
constexpr size_t SZ_U = (size_t)NTOK * DIN * 2;
constexpr size_t SZ_H = (size_t)NTOK * DM * 2;
constexpr size_t WS_MOD = 0;
constexpr size_t WS_RK = 2 * MiB;
constexpr size_t WS_WIN = 5 * MiB;
constexpr size_t WS_WOUT = 16 * MiB;
constexpr size_t WS_WGU = 20 * MiB;
constexpr size_t WS_WDN = 42 * MiB;
constexpr size_t WS_WLR = 53 * MiB;
constexpr size_t WS_U = 56 * MiB;
constexpr size_t WS_H = 411 * MiB;
constexpr size_t WS_TMP = 541 * MiB;
constexpr size_t WS_LA = 671 * MiB;
constexpr size_t WS_DEC = 704 * MiB;
constexpr size_t WS_AG = 834 * MiB;
constexpr size_t WS_END = 964 * MiB;
static_assert(WS_U + SZ_U <= WS_H && WS_H + SZ_H <= WS_TMP && WS_TMP + SZ_H <= WS_LA && WS_LA + (size_t)NTOK * 256 * 2 <= WS_DEC && WS_DEC + (size_t)NTOK * 512 * 4 <= WS_AG && WS_AG + SZ_H <= WS_END, "ws map");

#define LAS __attribute__((address_space(3)))
typedef unsigned short bf16;
typedef unsigned v4u __attribute__((ext_vector_type(4)));
typedef unsigned v2u __attribute__((ext_vector_type(2)));
typedef float f32x4 __attribute__((ext_vector_type(4)));
typedef float f32x2 __attribute__((ext_vector_type(2)));

struct Params {
    const float *x_prompt, *x_sample, *cache_conv, *state_shift, *state_wkv, *c_prompt, *c_sample;
    const float *w_mod, *b_mod, *g_mix_pre, *g_mix_post, *g_ffn_pre, *g_ffn_post, *w_in, *conv_dw, *conv_b, *conv_ln_g, *conv_ln_b;
    const float *mu_shift, *w0, *w2, *a0, *a2, *g2, *k_k, *k_a, *r_k, *lnx_g, *lnx_b, *w_out, *w_gate, *w_up, *w_down;
    float* out; unsigned char* ws;
};

__device__ __forceinline__ unsigned f2bf(float f) { unsigned u = __builtin_bit_cast(unsigned, f); return (u + 0x7fffu + ((u >> 16) & 1u)) >> 16; }
__device__ __forceinline__ unsigned pk2(float lo, float hi) { return f2bf(lo) | (f2bf(hi) << 16); }
__device__ __forceinline__ float bflo(unsigned w) { return __uint_as_float(w << 16); }
__device__ __forceinline__ float bfhi(unsigned w) { return __uint_as_float(w & 0xffff0000u); }
__device__ __forceinline__ float bf1(bf16 b) { return __uint_as_float((unsigned)b << 16); }
__device__ __forceinline__ float sigm(float x) { return __builtin_amdgcn_rcpf(1.0f + __expf(-x)); }
__device__ __forceinline__ float fma_s(float a, float b, float c) { float d; asm("v_fma_f32 %0, %1, %2, %3" : "=v"(d) : "v"(a), "v"(b), "v"(c)); return d; }
__device__ __forceinline__ float mul_s(float a, float b) { float d; asm("v_mul_f32_e32 %0, %1, %2" : "=v"(d) : "v"(a), "v"(b)); return d; }
__device__ __forceinline__ float sub_s(float a, float b) { float d; asm("v_sub_f32_e32 %0, %1, %2" : "=v"(d) : "v"(a), "v"(b)); return d; }
__device__ __forceinline__ float shfl_lane(float v, int srclane) { return __int_as_float(__builtin_amdgcn_ds_bpermute(srclane << 2, __float_as_int(v))); }
__device__ __forceinline__ float wave_sum(float v, int lane) {
#pragma unroll
    for (int o = 1; o < 64; o <<= 1) v += shfl_lane(v, lane ^ o);
    return v;
}
template <int CTRL> __device__ __forceinline__ float dppf(float x) { return __int_as_float(__builtin_amdgcn_update_dpp(0, __float_as_int(x), CTRL, 0xf, 0xf, true)); }
__device__ __forceinline__ float sum8(float x) { x += dppf<0xB1>(x); x += dppf<0x4E>(x); x += dppf<0x141>(x); return x; }
__device__ __forceinline__ float sum16(float x) { x = sum8(x); x += dppf<0x140>(x); return x; }
__device__ __forceinline__ void unpack8(const v4u w, float* f) { f[0] = bflo(w.x); f[1] = bfhi(w.x); f[2] = bflo(w.y); f[3] = bfhi(w.y); f[4] = bflo(w.z); f[5] = bfhi(w.z); f[6] = bflo(w.w); f[7] = bfhi(w.w); }
__device__ __forceinline__ v4u pack8(const float* f) { v4u w; w.x = pk2(f[0], f[1]); w.y = pk2(f[2], f[3]); w.z = pk2(f[4], f[5]); w.w = pk2(f[6], f[7]); return w; }


constexpr int PTAB_OFF = LDS_BYTES - 512;
__device__ __forceinline__ unsigned long long ldp_(LAS unsigned char* lds, int i) { const LAS unsigned* t = (const LAS unsigned*)(lds + PTAB_OFF) + 2 * i; const unsigned lo = __builtin_amdgcn_readfirstlane(t[0]), hi = __builtin_amdgcn_readfirstlane(t[1]); return ((unsigned long long)hi << 32) | lo; }
__device__ __forceinline__ Params load_params(LAS unsigned char* lds) { Params q;
    q.x_prompt = (const float*)(const __attribute__((address_space(1))) float*)ldp_(lds, 0);
    q.x_sample = (const float*)(const __attribute__((address_space(1))) float*)ldp_(lds, 1);
    q.cache_conv = (const float*)(const __attribute__((address_space(1))) float*)ldp_(lds, 2);
    q.state_shift = (const float*)(const __attribute__((address_space(1))) float*)ldp_(lds, 3);
    q.state_wkv = (const float*)(const __attribute__((address_space(1))) float*)ldp_(lds, 4);
    q.c_prompt = (const float*)(const __attribute__((address_space(1))) float*)ldp_(lds, 5);
    q.c_sample = (const float*)(const __attribute__((address_space(1))) float*)ldp_(lds, 6);
    q.w_mod = (const float*)(const __attribute__((address_space(1))) float*)ldp_(lds, 7);
    q.b_mod = (const float*)(const __attribute__((address_space(1))) float*)ldp_(lds, 8);
    q.g_mix_pre = (const float*)(const __attribute__((address_space(1))) float*)ldp_(lds, 9);
    q.g_mix_post = (const float*)(const __attribute__((address_space(1))) float*)ldp_(lds, 10);
    q.g_ffn_pre = (const float*)(const __attribute__((address_space(1))) float*)ldp_(lds, 11);
    q.g_ffn_post = (const float*)(const __attribute__((address_space(1))) float*)ldp_(lds, 12);
    q.w_in = (const float*)(const __attribute__((address_space(1))) float*)ldp_(lds, 13);
    q.conv_dw = (const float*)(const __attribute__((address_space(1))) float*)ldp_(lds, 14);
    q.conv_b = (const float*)(const __attribute__((address_space(1))) float*)ldp_(lds, 15);
    q.conv_ln_g = (const float*)(const __attribute__((address_space(1))) float*)ldp_(lds, 16);
    q.conv_ln_b = (const float*)(const __attribute__((address_space(1))) float*)ldp_(lds, 17);
    q.mu_shift = (const float*)(const __attribute__((address_space(1))) float*)ldp_(lds, 18);
    q.w0 = (const float*)(const __attribute__((address_space(1))) float*)ldp_(lds, 19);
    q.w2 = (const float*)(const __attribute__((address_space(1))) float*)ldp_(lds, 20);
    q.a0 = (const float*)(const __attribute__((address_space(1))) float*)ldp_(lds, 21);
    q.a2 = (const float*)(const __attribute__((address_space(1))) float*)ldp_(lds, 22);
    q.g2 = (const float*)(const __attribute__((address_space(1))) float*)ldp_(lds, 23);
    q.k_k = (const float*)(const __attribute__((address_space(1))) float*)ldp_(lds, 24);
    q.k_a = (const float*)(const __attribute__((address_space(1))) float*)ldp_(lds, 25);
    q.r_k = (const float*)(const __attribute__((address_space(1))) float*)ldp_(lds, 26);
    q.lnx_g = (const float*)(const __attribute__((address_space(1))) float*)ldp_(lds, 27);
    q.lnx_b = (const float*)(const __attribute__((address_space(1))) float*)ldp_(lds, 28);
    q.w_out = (const float*)(const __attribute__((address_space(1))) float*)ldp_(lds, 29);
    q.w_gate = (const float*)(const __attribute__((address_space(1))) float*)ldp_(lds, 30);
    q.w_up = (const float*)(const __attribute__((address_space(1))) float*)ldp_(lds, 31);
    q.w_down = (const float*)(const __attribute__((address_space(1))) float*)ldp_(lds, 32);
    q.out = (float*)(__attribute__((address_space(1))) float*)ldp_(lds, 33);
    q.ws = (unsigned char*)(__attribute__((address_space(1))) unsigned char*)ldp_(lds, 34);
    return q; }
__device__ __forceinline__ void store_params(const Params& p, LAS unsigned char* lds) { LAS unsigned long long* t = (LAS unsigned long long*)(lds + PTAB_OFF);
    t[0] = (unsigned long long)p.x_prompt;
    t[1] = (unsigned long long)p.x_sample;
    t[2] = (unsigned long long)p.cache_conv;
    t[3] = (unsigned long long)p.state_shift;
    t[4] = (unsigned long long)p.state_wkv;
    t[5] = (unsigned long long)p.c_prompt;
    t[6] = (unsigned long long)p.c_sample;
    t[7] = (unsigned long long)p.w_mod;
    t[8] = (unsigned long long)p.b_mod;
    t[9] = (unsigned long long)p.g_mix_pre;
    t[10] = (unsigned long long)p.g_mix_post;
    t[11] = (unsigned long long)p.g_ffn_pre;
    t[12] = (unsigned long long)p.g_ffn_post;
    t[13] = (unsigned long long)p.w_in;
    t[14] = (unsigned long long)p.conv_dw;
    t[15] = (unsigned long long)p.conv_b;
    t[16] = (unsigned long long)p.conv_ln_g;
    t[17] = (unsigned long long)p.conv_ln_b;
    t[18] = (unsigned long long)p.mu_shift;
    t[19] = (unsigned long long)p.w0;
    t[20] = (unsigned long long)p.w2;
    t[21] = (unsigned long long)p.a0;
    t[22] = (unsigned long long)p.a2;
    t[23] = (unsigned long long)p.g2;
    t[24] = (unsigned long long)p.k_k;
    t[25] = (unsigned long long)p.k_a;
    t[26] = (unsigned long long)p.r_k;
    t[27] = (unsigned long long)p.lnx_g;
    t[28] = (unsigned long long)p.lnx_b;
    t[29] = (unsigned long long)p.w_out;
    t[30] = (unsigned long long)p.w_gate;
    t[31] = (unsigned long long)p.w_up;
    t[32] = (unsigned long long)p.w_down;
    t[33] = (unsigned long long)p.out;
    t[34] = (unsigned long long)p.ws;
}

struct Tok { int b, t, bb, smp; };
__device__ __forceinline__ Tok tokinfo(int m) { Tok k; if (m < NP) { k.b = m >> 12; k.t = m & 4095; k.bb = k.b; k.smp = 0; } else { const int mm = m - NP; k.b = mm >> 6; k.t = mm & 63; k.bb = BP + k.b; k.smp = 1; } return k; }

template <int MODE>
__device__ __forceinline__ void transpose_item(const float* W, int K, int N, bf16* WT, LAS float* scr, int item, int lane) {
    const int nblk = N / 32, kb = item / nblk, nb = item % nblk, k0 = 64 * kb, n0 = 32 * nb;
#pragma unroll 8
    for (int i = 0; i < 32; ++i) { const int kk = 2 * i + (lane >> 5); scr[kk * 33 + (lane & 31)] = W[(size_t)(k0 + kk) * N + n0 + (lane & 31)]; }
    asm volatile("s_waitcnt lgkmcnt(0)" ::: "memory");
    const int c = lane & 7;
    const int rbase = (MODE == 0) ? n0 : ((n0 >> 7) * 256 + (MODE - 1) * 128 + (n0 & 127));
#pragma unroll
    for (int j = 0; j < 4; ++j) { const int n = (lane >> 3) + 8 * j; const LAS float* s = scr + (8 * c) * 33 + n;
        v4u o; o.x = pk2(s[0 * 33], s[1 * 33]); o.y = pk2(s[2 * 33], s[3 * 33]); o.z = pk2(s[4 * 33], s[5 * 33]); o.w = pk2(s[6 * 33], s[7 * 33]);
        *(v4u*)(WT + (size_t)(rbase + n) * K + k0 + 8 * c) = o; }
    asm volatile("s_waitcnt lgkmcnt(0)" ::: "memory");
}

__device__ __forceinline__ void phase_weights(LAS unsigned char* lds, int L, int wg0, int nwg) {
    const Params p = load_params(lds); int tid_ = threadIdx.x; asm volatile("" : "+v"(tid_)); const int tid = tid_, lane = tid & 63, wave = __builtin_amdgcn_readfirstlane(tid >> 6);
    LAS float* scr = (LAS float*)(lds + wave * 16384);
    const int gw = ((int)blockIdx.x - wg0) * NWAVES + wave, NGW = nwg * NWAVES;
    constexpr int I_IN = (DM / 64) * (DIN / 32), I_OUT = (DM / 64) * (DM / 32), I_G = (DM / 64) * (DFF / 32), I_DN = (DFF / 64) * (DM / 32);
    constexpr int PER_L = I_IN + I_OUT + 2 * I_G + I_DN;
    for (int it = gw; it < PER_L; it += NGW) {
        const int l = L; int r = it;
        if (r < I_IN) { transpose_item<0>(p.w_in + (size_t)l * DM * DIN, DM, DIN, (bf16*)(p.ws + WS_WIN) + (size_t)l * DIN * DM, scr, r, lane); continue; } r -= I_IN;
        if (r < I_OUT) { transpose_item<0>(p.w_out + (size_t)l * DM * DM, DM, DM, (bf16*)(p.ws + WS_WOUT) + (size_t)l * DM * DM, scr, r, lane); continue; } r -= I_OUT;
        if (r < I_G) { transpose_item<1>(p.w_gate + (size_t)l * DM * DFF, DM, DFF, (bf16*)(p.ws + WS_WGU) + (size_t)l * 2 * DFF * DM, scr, r, lane); continue; } r -= I_G;
        if (r < I_G) { transpose_item<2>(p.w_up + (size_t)l * DM * DFF, DM, DFF, (bf16*)(p.ws + WS_WGU) + (size_t)l * 2 * DFF * DM, scr, r, lane); continue; } r -= I_G;
        transpose_item<0>(p.w_down + (size_t)l * DFF * DM, DFF, DM, (bf16*)(p.ws + WS_WDN) + (size_t)l * DM * DFF, scr, r, lane);
    }
    bf16* WLR = (bf16*)(p.ws + WS_WLR);
    for (int i0 = ((int)blockIdx.x - wg0) * NTHR + tid; i0 < 1536 * 256; i0 += nwg * NTHR) {
        const int l = L, r = i0, i = L * 1536 * 256 + i0, n = r >> 8, k = r & 255; float v = 0.f;
        if (n < 512) { if (k < 64) v = p.w2[((size_t)l * 64 + k) * 512 + n]; }
        else if (n < 1024) { if (k >= 64 && k < 128) v = p.a2[((size_t)l * 64 + (k - 64)) * 512 + (n - 512)]; }
        else { if (k >= 128) v = p.g2[((size_t)l * 128 + (k - 128)) * 512 + (n - 1024)]; }
        WLR[i] = (bf16)f2bf(v);
    }
}

__device__ __forceinline__ void phase_mod(LAS unsigned char* lds, int wg0) {
    const Params p = load_params(lds); int tid_ = threadIdx.x; asm volatile("" : "+v"(tid_)); const int tid = tid_;
    const int u0 = (int)blockIdx.x - wg0; if (u0 < 0 || u0 >= 96) return;
    LAS float* sc = (LAS float*)lds;
    LAS float* red = (LAS float*)(lds + 24 * 1024 * 4);
    for (int i = tid; i < NB * DM; i += NTHR) { const int bb = i >> 10, e = i & 1023; const float c = bb < BP ? p.c_prompt[bb * DM + e] : p.c_sample[(bb - BP) * DM + e]; sc[i] = c * sigm(c); }
    __syncthreads();
    float* mod = (float*)(p.ws + WS_MOD);
    for (int unit = u0; unit < 96; unit += 96) {
        const int l = unit / 48, blk = unit % 48, kq = tid >> 7, cc = tid & 127, j = blk * 128 + cc;
        const float* W = p.w_mod + (size_t)l * DM * 6144 + j;
        float acc[NB];
#pragma unroll
        for (int bb = 0; bb < NB; ++bb) acc[bb] = 0.f;
        for (int i = kq * 256; i < kq * 256 + 256; i += 4) {
            const float w0 = W[(size_t)i * 6144], w1 = W[(size_t)(i + 1) * 6144], w2 = W[(size_t)(i + 2) * 6144], w3 = W[(size_t)(i + 3) * 6144];
#pragma unroll
            for (int bb = 0; bb < NB; ++bb) { const f32x4 s = *(const LAS f32x4*)(sc + bb * DM + i); acc[bb] += s.x * w0 + s.y * w1 + s.z * w2 + s.w * w3; }
        }
        if (kq > 0) {
#pragma unroll
            for (int bb = 0; bb < NB; ++bb) red[((kq - 1) * NB + bb) * 128 + cc] = acc[bb];
        }
        __syncthreads();
        if (kq == 0) {
            const float bm = p.b_mod[l * 6144 + j];
#pragma unroll
            for (int bb = 0; bb < NB; ++bb) mod[((size_t)l * NB + bb) * 6144 + j] = acc[bb] + red[(0 * NB + bb) * 128 + cc] + red[(1 * NB + bb) * 128 + cc] + red[(2 * NB + bb) * 128 + cc] + bm;
        }
        __syncthreads();
    }
}

template <int STAGE>
__device__ __forceinline__ void phase_rows(LAS unsigned char* lds, int l) {
    const Params p = load_params(lds); int tid_ = threadIdx.x; asm volatile("" : "+v"(tid_)); const int tid = tid_, lane = tid & 63, wave = __builtin_amdgcn_readfirstlane(tid >> 6);
    const int gw = blockIdx.x * NWAVES + wave, NGW = gridDim.x * NWAVES;
    const float* mod = (const float*)(p.ws + WS_MOD);
    bf16* H = (bf16*)(p.ws + WS_H); const bf16* TMP = (const bf16*)(p.ws + WS_TMP);
    constexpr int NR = 2;
    const bool x_from_in = (STAGE == 0 || (STAGE == 1 && l == 0));
    const float* gpost = (STAGE == 1 ? p.g_mix_post : p.g_ffn_post) + l * DM;
    const int ln = (STAGE == 2) ? l + 1 : l;
    const float* gpre = (STAGE == 1 ? p.g_ffn_pre : p.g_mix_pre) + ln * DM;
    const bool doH = !(STAGE == 2 && l == 1);
    f32x4 gpo[4], gpr[4];
#pragma unroll
    for (int j = 0; j < 4; ++j) { gpo[j] = (STAGE != 0) ? *(const f32x4*)(gpost + 4 * lane + 256 * j) : (f32x4){0.f, 0.f, 0.f, 0.f}; gpr[j] = doH ? *(const f32x4*)(gpre + 4 * lane + 256 * j) : (f32x4){0.f, 0.f, 0.f, 0.f}; }
    v2u nxb[NR][4], ntw[NR][4];
#define ROWS_PF(mb_) do { _Pragma("unroll") for (int r = 0; r < NR; ++r) { int m_ = (mb_) + r * NGW; if (m_ >= NTOK) m_ = gw; \
            if (!x_from_in) { const bf16* xb = (const bf16*)(p.out + (size_t)m_ * DM); _Pragma("unroll") for (int j = 0; j < 4; ++j) nxb[r][j] = __builtin_nontemporal_load((const v2u*)(xb + 4 * lane + 256 * j)); } \
            if (STAGE != 0) { _Pragma("unroll") for (int j = 0; j < 4; ++j) ntw[r][j] = __builtin_nontemporal_load((const v2u*)(TMP + (size_t)m_ * DM + 4 * lane + 256 * j)); } } } while (0)
    ROWS_PF(gw);
    for (int mb = gw; mb < NTOK; mb += NR * NGW) {
        int mm[NR]; bool ok[NR]; f32x4 v[NR][4], ga[NR][4], sh[NR][4], sc[NR][4]; v2u tw[NR][4];
#pragma unroll
        for (int r = 0; r < NR; ++r) { const int m = mb + r * NGW; ok[r] = m < NTOK; mm[r] = ok[r] ? m : mb; const int bb = tokinfo(mm[r]).bb;
#pragma unroll
            for (int j = 0; j < 4; ++j) { v[r][j] = (f32x4){bflo(nxb[r][j].x), bfhi(nxb[r][j].x), bflo(nxb[r][j].y), bfhi(nxb[r][j].y)}; tw[r][j] = ntw[r][j]; }
            if (x_from_in) { const float* xr = mm[r] < NP ? p.x_prompt + (size_t)mm[r] * DM : p.x_sample + (size_t)(mm[r] - NP) * DM;
#pragma unroll
                for (int j = 0; j < 4; ++j) v[r][j] = __builtin_nontemporal_load((const f32x4*)(xr + 4 * lane + 256 * j)); }
            if (STAGE != 0) { const float* mga = mod + ((size_t)l * NB + bb) * 6144 + (STAGE == 1 ? 2 : 5) * DM;
#pragma unroll
                for (int j = 0; j < 4; ++j) ga[r][j] = *(const f32x4*)(mga + 4 * lane + 256 * j); }
            if (doH) { const float* msh = mod + ((size_t)ln * NB + bb) * 6144 + (STAGE == 1 ? 3 : 0) * DM; const float* msc = mod + ((size_t)ln * NB + bb) * 6144 + (STAGE == 1 ? 4 : 1) * DM;
#pragma unroll
                for (int j = 0; j < 4; ++j) { sh[r][j] = *(const f32x4*)(msh + 4 * lane + 256 * j); sc[r][j] = *(const f32x4*)(msc + 4 * lane + 256 * j); } } }
        if (mb + NR * NGW < NTOK) ROWS_PF(mb + NR * NGW);
        if (STAGE != 0) {
            float ss[NR];
#pragma unroll
            for (int r = 0; r < NR; ++r) { ss[r] = 0.f;
#pragma unroll
                for (int j = 0; j < 4; ++j) { const float a = bflo(tw[r][j].x), b2 = bfhi(tw[r][j].x), c = bflo(tw[r][j].y), d = bfhi(tw[r][j].y); ss[r] += (a * a + b2 * b2) + (c * c + d * d); } }
#pragma unroll
            for (int r = 0; r < NR; ++r) ss[r] = wave_sum(ss[r], lane);
#pragma unroll
            for (int r = 0; r < NR; ++r) { const float rs = 1.0f / sqrtf(ss[r] * (1.0f / DM) + 1e-6f);
#pragma unroll
                for (int j = 0; j < 4; ++j) { const f32x4 tv = (f32x4){bflo(tw[r][j].x), bfhi(tw[r][j].x), bflo(tw[r][j].y), bfhi(tw[r][j].y)};
                    v[r][j] = v[r][j] + (1.0f + ga[r][j]) * (tv * rs * gpo[j]);
                    if (ok[r]) { if (STAGE == 2 && l == 1) __builtin_nontemporal_store(v[r][j], (f32x4*)(p.out + (size_t)mm[r] * DM + 4 * lane + 256 * j));
                        else { v2u w; w.x = pk2(v[r][j].x, v[r][j].y); w.y = pk2(v[r][j].z, v[r][j].w); *(v2u*)((bf16*)(p.out + (size_t)mm[r] * DM) + 4 * lane + 256 * j) = w;
                            v[r][j] = (f32x4){bflo(w.x), bfhi(w.x), bflo(w.y), bfhi(w.y)}; } } } }
        }
        if (doH) {
            float ss[NR];
#pragma unroll
            for (int r = 0; r < NR; ++r) { ss[r] = 0.f;
#pragma unroll
                for (int j = 0; j < 4; ++j) ss[r] += (v[r][j].x * v[r][j].x + v[r][j].y * v[r][j].y) + (v[r][j].z * v[r][j].z + v[r][j].w * v[r][j].w); }
#pragma unroll
            for (int r = 0; r < NR; ++r) ss[r] = wave_sum(ss[r], lane);
#pragma unroll
            for (int r = 0; r < NR; ++r) { const float rs = 1.0f / sqrtf(ss[r] * (1.0f / DM) + 1e-6f);
#pragma unroll
                for (int j = 0; j < 4; ++j) { const f32x4 h = (v[r][j] * rs * gpr[j]) * (1.0f + sc[r][j]) + sh[r][j];
                    v2u w; w.x = pk2(h.x, h.y); w.y = pk2(h.z, h.w);
                    if (ok[r]) *(v2u*)(H + (size_t)mm[r] * DM + 4 * lane + 256 * j) = w; } }
        }
    }
#undef ROWS_PF
}

#define XB_TMO      128
#define XB_XCNT(j)  (256  + 64 * (j))
#define XB_XSUB(j)  (1280 + 64 * (j))
#define XB_XGEN(j)  (2304 + 64 * (j))
#define XB_TOP      3328
#define XB_TOPGEN   3392
#define XCD_BAR_WORDS 3456
#define XB_SPIN_CAP (1u << 18)

__device__ __forceinline__ unsigned xb_ld(unsigned* p)              { return __hip_atomic_load(p, __ATOMIC_RELAXED, __HIP_MEMORY_SCOPE_AGENT); }
__device__ __forceinline__ unsigned xb_add(unsigned* p, unsigned v) { return __hip_atomic_fetch_add(p, v, __ATOMIC_RELAXED, __HIP_MEMORY_SCOPE_AGENT); }
__device__ __forceinline__ unsigned xb_xcc_id() { return (unsigned)__builtin_amdgcn_s_getreg((3 << 11) | 20) & 0xFu; }
#define XB_SPIN(cond, bar) do { unsigned _sp = 0; while (cond) { __builtin_amdgcn_s_sleep(1); \
    if ((++_sp & 255u) == 0u) { if (xb_ld(&(bar)[XB_TMO])) break; if (_sp > XB_SPIN_CAP) { atomicAdd(&(bar)[XB_TMO], 1u); break; } } } } while (0)

struct XcdBarrier {
    unsigned* bar; unsigned x;
    volatile LAS unsigned* st;
};

__device__ __forceinline__ XcdBarrier xcd_barrier_post(unsigned* bar, volatile LAS unsigned* st) {
    XcdBarrier b; b.bar = bar; b.x = xb_xcc_id(); b.st = st;
    if (threadIdx.x == 0) (void)xb_add(&bar[XB_XCNT(b.x)], 1u);
    return b;
}
__device__ __forceinline__ void xcd_barrier_complete(unsigned* bar, unsigned x, unsigned& nloc, unsigned& nx) {
    const unsigned G = gridDim.x * gridDim.y * gridDim.z;
    unsigned sum, cnt, mine, sp = 0u;
    for (;;) {
        sum = 0u; cnt = 0u; mine = 0u;
#pragma unroll
        for (unsigned j = 0; j < 16; ++j) { const unsigned c = xb_ld(&bar[XB_XCNT(j)]); sum += c; cnt += (c > 0u) ? 1u : 0u; mine = (j == x) ? c : mine; }
        if (sum == G) break;
        __builtin_amdgcn_s_sleep(1);
        if ((++sp & 255u) == 0u) { if (xb_ld(&bar[XB_TMO])) break; if (sp > XB_SPIN_CAP) { atomicAdd(&bar[XB_TMO], 1u); break; } }
    }
    nloc = mine > 0u ? mine : 1u; nx = cnt > 0u ? cnt : 1u;
}

__device__ __forceinline__ void xcd_barrier(const XcdBarrier& b) {
    asm volatile("s_waitcnt vmcnt(0)" ::: "memory");
    __syncthreads();
    if (threadIdx.x == 0) {
        unsigned* bar = b.bar;
        __builtin_amdgcn_s_waitcnt(0);
        unsigned nloc = b.st[0], nx = b.st[1];
        if (nloc == 0u) { xcd_barrier_complete(bar, b.x, nloc, nx); b.st[0] = nloc; b.st[1] = nx; }
        const unsigned old = xb_add(&bar[XB_XSUB(b.x)], 1u);
        const unsigned gen = old / nloc;
        if (old + 1u == (gen + 1u) * nloc) {
            __builtin_amdgcn_fence(__ATOMIC_RELEASE, "agent");
            asm volatile("s_waitcnt vmcnt(0)" ::: "memory");
            const unsigned og = xb_add(&bar[XB_TOP], 1u);
            const unsigned tg = og / nx;
            if (og + 1u == (tg + 1u) * nx) xb_add(&bar[XB_TOPGEN], 1u);
            else XB_SPIN(xb_ld(&bar[XB_TOPGEN]) == tg, bar);
            __builtin_amdgcn_fence(__ATOMIC_ACQUIRE, "agent");
            xb_add(&bar[XB_XGEN(b.x)], 1u);
            asm volatile("s_waitcnt vmcnt(0)" ::: "memory");
        } else {
            XB_SPIN(xb_ld(&bar[XB_XGEN(b.x)]) == gen, bar);
            __builtin_amdgcn_fence(__ATOMIC_ACQUIRE, "agent");
            asm volatile("s_waitcnt vmcnt(0)" ::: "memory");
        }
    }
    __syncthreads();
}


__device__ __forceinline__ void phase_conv(LAS unsigned char* lds, int l, unsigned* ctr) {
    const Params p = load_params(lds); int tid_ = threadIdx.x; asm volatile("" : "+v"(tid_)); const int tid = tid_, lane = tid & 63, wave = __builtin_amdgcn_readfirstlane(tid >> 6);
    LAS float* G = (LAS float*)lds;
    const bf16* U = (const bf16*)(p.ws + WS_U); bf16* MIX = (bf16*)(p.ws + WS_H);
    constexpr int NU = BP * (TP / 32) + BS * (TS / 32);
    float wj[CW];
#pragma unroll
    for (int j = 0; j < CW; ++j) wj[j] = p.conv_dw[((size_t)l * CW + j) * DCV + tid];
    const float cb = p.conv_b[l * DCV + tid];
    float lg[8], lb[8];
#pragma unroll
    for (int i = 0; i < 8; ++i) { lg[i] = p.conv_ln_g[l * DCV + 8 * lane + i]; lb[i] = p.conv_ln_b[l * DCV + 8 * lane + i]; }
    volatile LAS unsigned* tq = (volatile LAS unsigned*)(lds + PTAB_OFF + 416);
    for (;;) {
        if (tid == 0) tq[0] = __hip_atomic_fetch_add(ctr, 1u, __ATOMIC_RELAXED, __HIP_MEMORY_SCOPE_AGENT);
        __syncthreads();
        const int unit = (int)tq[0];
        __syncthreads();
        if (unit >= NU) break;
        int smp, b, t0, T, mbase;
        if (unit < BP * (TP / 32)) { smp = 0; b = unit >> 7; t0 = (unit & 127) * 32; T = TP; mbase = b * TP; }
        else { const int v = unit - BP * (TP / 32); smp = 1; b = v >> 1; t0 = (v & 1) * 32; T = TS; mbase = NP + b * TS; }
        const bool last = (t0 + 32 == T);
        float* cout = p.out + (smp ? O_CONVS + ((size_t)l * BS + b) * CBUF * DCV : O_CONVP + ((size_t)l * BP + b) * CBUF * DCV);
#pragma unroll 1
        for (int itb = tid; itb < 62 * 64; itb += 4 * NTHR) {
            v4u ua[4], us[4]; f32x4 c0[4], c1[4];
#pragma unroll
            for (int q = 0; q < 4; ++q) { const int it = itb + q * NTHR; const int i = it >> 6, c8 = it & 63, tok = t0 - CBUF + i;
                ua[q] = (v4u){0u, 0u, 0u, 0u}; us[q] = ua[q]; c0[q] = (f32x4){0.f, 0.f, 0.f, 0.f}; c1[q] = c0[q];
                if (it < 62 * 64) {
                    if (tok >= 0) { const bf16* ur = U + (size_t)(mbase + tok) * DIN + 8 * c8; ua[q] = *(const v4u*)ur; us[q] = *(const v4u*)(ur + DCV); }
                    else if (smp) { const float* cr = p.cache_conv + (((size_t)l * BS + b) * CBUF + (CBUF + tok)) * DCV + 8 * c8; c0[q] = *(const f32x4*)cr; c1[q] = *(const f32x4*)(cr + 4); } } }
#pragma unroll
            for (int q = 0; q < 4; ++q) { const int it = itb + q * NTHR; const int i = it >> 6, c8 = it & 63, tok = t0 - CBUF + i; float g[8];
                if (it < 62 * 64) {
                    if (tok >= 0) { float a[8], sg[8]; unpack8(ua[q], a); unpack8(us[q], sg);
#pragma unroll
                        for (int e = 0; e < 8; ++e) g[e] = a[e] * sigm(sg[e]); }
                    else { g[0] = c0[q].x; g[1] = c0[q].y; g[2] = c0[q].z; g[3] = c0[q].w; g[4] = c1[q].x; g[5] = c1[q].y; g[6] = c1[q].z; g[7] = c1[q].w; }
                    *(LAS f32x4*)(G + i * DCV + 8 * c8) = (f32x4){g[0], g[1], g[2], g[3]};
                    *(LAS f32x4*)(G + i * DCV + 8 * c8 + 4) = (f32x4){g[4], g[5], g[6], g[7]};
                    if (last && i >= 32) { float* o = cout + (size_t)(i - 32) * DCV + 8 * c8; *(f32x4*)o = (f32x4){g[0], g[1], g[2], g[3]}; *(f32x4*)(o + 4) = (f32x4){g[4], g[5], g[6], g[7]}; } } }
        }
        __syncthreads();
        float acc[32];
#pragma unroll
        for (int t = 0; t < 32; ++t) acc[t] = cb;
#pragma unroll
        for (int i = 0; i < 62; ++i) {
            const float g = G[i * DCV + tid];
#pragma unroll
            for (int t = 0; t < 32; ++t) { if (i - t >= 0 && i - t < CW) acc[t] += wj[i - t] * g; }
        }
        __syncthreads();
#pragma unroll
        for (int t = 0; t < 32; ++t) G[t * DCV + tid] = acc[t];
        __syncthreads();
#pragma unroll
        for (int q = 0; q < 4; ++q) {
            const int t = wave * 4 + q;
            const f32x4 y0 = *(const LAS f32x4*)(G + t * DCV + 8 * lane), y1 = *(const LAS f32x4*)(G + t * DCV + 8 * lane + 4);
            float y[8] = {y0.x, y0.y, y0.z, y0.w, y1.x, y1.y, y1.z, y1.w};
            float s = 0.f;
#pragma unroll
            for (int i = 0; i < 8; ++i) s += y[i];
            const float mean = wave_sum(s, lane) * (1.0f / DCV); float q2 = 0.f;
#pragma unroll
            for (int i = 0; i < 8; ++i) { y[i] -= mean; q2 += y[i] * y[i]; }
            const float rstd = 1.0f / sqrtf(wave_sum(q2, lane) * (1.0f / DCV) + 1e-5f);
            float o[8];
#pragma unroll
            for (int i = 0; i < 8; ++i) { const float z = y[i] * rstd * lg[i] + lb[i]; o[i] = z * sigm(z); }
            *(v4u*)(MIX + (size_t)(mbase + t0 + t) * DM + 8 * lane) = pack8(o);
        }
        __syncthreads();
    }
}

__device__ __forceinline__ void zprev8(const Params& p, int l, const bf16* U, int m, const Tok& k, int col, float* f) {
    if (k.t > 0) unpack8(*(const v4u*)(U + (size_t)(m - 1) * DIN + 1024 + col), f);
    else if (k.smp) { const float* s = p.state_shift + ((size_t)l * BS + k.b) * DSH + col; const f32x4 a = *(const f32x4*)s, b2 = *(const f32x4*)(s + 4);
        f[0] = a.x; f[1] = a.y; f[2] = a.z; f[3] = a.w; f[4] = b2.x; f[5] = b2.y; f[6] = b2.z; f[7] = b2.w; }
    else {
#pragma unroll
        for (int q = 0; q < 8; ++q) f[q] = 0.f; }
}

__device__ __forceinline__ void phase_prepA(LAS unsigned char* lds, int l) {
    const Params p = load_params(lds); int tid_ = threadIdx.x; asm volatile("" : "+v"(tid_)); const int tid = tid_;
    const bf16* U = (const bf16*)(p.ws + WS_U); bf16* LA = (bf16*)(p.ws + WS_LA);
    const int c8 = tid & 31, col = 1536 + 8 * c8;
    float mu[8];
#pragma unroll
    for (int q = 0; q < 8; ++q) mu[q] = p.mu_shift[(size_t)l * DSH + col + q];
    const int nstr = gridDim.x * NTHR;
    for (int itb = blockIdx.x * NTHR + tid; itb < NTOK * 32; itb += 4 * nstr) {
        v4u uz[4]; float zp[4][8]; bool ok[4]; int mm[4];
#pragma unroll
        for (int r = 0; r < 4; ++r) { const int it = itb + r * nstr; ok[r] = it < NTOK * 32; mm[r] = ok[r] ? (it >> 5) : (itb >> 5); const Tok k = tokinfo(mm[r]);
            uz[r] = *(const v4u*)(U + (size_t)mm[r] * DIN + 1024 + col); zprev8(p, l, U, mm[r], k, col, zp[r]); }
#pragma unroll
        for (int r = 0; r < 4; ++r) { float z[8], o[8]; unpack8(uz[r], z);
#pragma unroll
            for (int q = 0; q < 8; ++q) { const float zm = z[q] + (zp[r][q] - z[q]) * mu[q];
                o[q] = (c8 < 8) ? (1.0f - 2.0f * __builtin_amdgcn_rcpf(__expf(2.0f * zm) + 1.0f)) : (c8 < 16 ? zm : sigm(zm)); }
            if (ok[r]) *(v4u*)(LA + (size_t)mm[r] * 256 + 8 * c8) = pack8(o); }
    }
    for (int it = blockIdx.x * NTHR + tid; it < NB * DSH; it += gridDim.x * NTHR) {
        const int bb = it / DSH, col = it % DSH;
        if (bb < BP) p.out[O_SHIFTP + ((size_t)l * BP + bb) * DSH + col] = bf1(U[(size_t)(bb * TP + TP - 1) * DIN + 1024 + col]);
        else p.out[O_SHIFTS + ((size_t)l * BS + (bb - BP)) * DSH + col] = bf1(U[(size_t)(NP + (bb - BP) * TS + TS - 1) * DIN + 1024 + col]);
    }
}

struct ScanRegs { v2u zr, zk, zv, pr, pk, pv, av; f32x4 dec; float s_r[4], s_k[4], s_v[4]; };
__device__ __forceinline__ void phase_scan(LAS unsigned char* lds, int l) {
    const Params p = load_params(lds); int tid_ = threadIdx.x; asm volatile("" : "+v"(tid_)); const int tid = tid_;
    const bf16* U = (const bf16*)(p.ws + WS_U); const float* DEC = (const float*)(p.ws + WS_DEC); const bf16* AG = (const bf16*)(p.ws + WS_AG);
    float* Y = (float*)(p.ws + WS_TMP); float* RK = (float*)(p.ws + WS_RK);
    constexpr int TC = 32, VEC_F = 5 * TC * 64, BUF_F = VEC_F + TC * 32;
    LAS float* B0 = (LAS float*)lds;
    const int lane = tid & 63, wave = __builtin_amdgcn_readfirstlane(tid >> 6);
    const int ps = tid >> 4, kq = tid & 15, k0 = 4 * kq;
    for (int unit = blockIdx.x; unit < 384; unit += gridDim.x) {
        int smp, b, h, half, T, m0;
        if (unit < 256) { smp = 0; b = unit >> 4; h = (unit >> 1) & 7; half = unit & 1; T = TP; m0 = b * TP; }
        else { const int v = unit - 256; smp = 1; b = v >> 4; h = (v >> 1) & 7; half = v & 1; T = TS; m0 = NP + b * TS; }
        const int hc = h * 64 + k0;
        float mu_r[4], mu_k[4], mu_v[4], kkw[4], kaw[4], rkw[4], w0w[4], a0w[4];
#pragma unroll
        for (int j = 0; j < 4; ++j) { mu_r[j] = p.mu_shift[(size_t)l * DSH + hc + j]; mu_k[j] = p.mu_shift[(size_t)l * DSH + 512 + hc + j]; mu_v[j] = p.mu_shift[(size_t)l * DSH + 1024 + hc + j];
            kkw[j] = p.k_k[l * DRW + hc + j]; kaw[j] = p.k_a[l * DRW + hc + j]; rkw[j] = p.r_k[l * DRW + hc + j];  w0w[j] = p.w0[l * DRW + hc + j]; a0w[j] = p.a0[l * DRW + hc + j]; }
        float S[4];
        float* sout = p.out + (smp ? O_WKVS + (((size_t)l * BS + b) * NH + h) * 4096 : O_WKVP + (((size_t)l * BP + b) * NH + h) * 4096) + (size_t)(half * 32 + ps) * 64 + k0;
        if (smp) { const f32x4 s0 = *(const f32x4*)(p.state_wkv + (((size_t)l * BS + b) * NH + h) * 4096 + (size_t)(half * 32 + ps) * 64 + k0); S[0] = s0.x; S[1] = s0.y; S[2] = s0.z; S[3] = s0.w; }
        else { S[0] = S[1] = S[2] = S[3] = 0.f; }
        const int nch = T / TC;
        ScanRegs R;
#define SCAN_LOAD(c) do { const int t_ = (c) * TC + ps; const int m_ = m0 + t_; const bf16* ur_ = U + (size_t)m_ * DIN + 1024 + hc; \
            R.zr = *(const v2u*)ur_; R.zk = *(const v2u*)(ur_ + 512); R.zv = *(const v2u*)(ur_ + 1024); \
            if (t_ > 0) { R.pr = *(const v2u*)(ur_ - DIN); R.pk = *(const v2u*)(ur_ - DIN + 512); R.pv = *(const v2u*)(ur_ - DIN + 1024); } \
            else if (smp) { const float* s_ = p.state_shift + ((size_t)l * BS + b) * DSH + hc; \
                R.pr = (v2u){0u, 0u}; R.pk = (v2u){0u, 0u}; R.pv = (v2u){0u, 0u}; \
                R.s_r[0] = s_[0]; R.s_r[1] = s_[1]; R.s_r[2] = s_[2]; R.s_r[3] = s_[3]; R.s_k[0] = s_[512]; R.s_k[1] = s_[513]; R.s_k[2] = s_[514]; R.s_k[3] = s_[515]; \
                R.s_v[0] = s_[1024]; R.s_v[1] = s_[1025]; R.s_v[2] = s_[1026]; R.s_v[3] = s_[1027]; } \
            else { R.pr = (v2u){0u, 0u}; R.pk = (v2u){0u, 0u}; R.pv = (v2u){0u, 0u}; } \
            R.dec = *(const f32x4*)(DEC + (size_t)m_ * 512 + hc); R.av = *(const v2u*)(AG + (size_t)m_ * 1024 + hc); } while (0)
#define SCAN_FINISH(c, buf) do { LAS float* B_ = B0 + (buf) * BUF_F; const int t_ = (c) * TC + ps; const int m_ = m0 + t_; \
            float zr_[4] = {bflo(R.zr.x), bfhi(R.zr.x), bflo(R.zr.y), bfhi(R.zr.y)}, zk_[4] = {bflo(R.zk.x), bfhi(R.zk.x), bflo(R.zk.y), bfhi(R.zk.y)}, zv_[4] = {bflo(R.zv.x), bfhi(R.zv.x), bflo(R.zv.y), bfhi(R.zv.y)}; \
            float pr_[4] = {bflo(R.pr.x), bfhi(R.pr.x), bflo(R.pr.y), bfhi(R.pr.y)}, pk_[4] = {bflo(R.pk.x), bfhi(R.pk.x), bflo(R.pk.y), bfhi(R.pk.y)}, pv_[4] = {bflo(R.pv.x), bfhi(R.pv.x), bflo(R.pv.y), bfhi(R.pv.y)}; \
            if (smp && t_ == 0) { _Pragma("unroll") for (int j = 0; j < 4; ++j) { pr_[j] = R.s_r[j]; pk_[j] = R.s_k[j]; pv_[j] = R.s_v[j]; } } \
            const float a_[4] = {sigm(bflo(R.av.x) + a0w[0]), sigm(bfhi(R.av.x) + a0w[1]), sigm(bflo(R.av.y) + a0w[2]), sigm(bfhi(R.av.y) + a0w[3])}; \
            float r_[4], kr_[4], v_[4], kk_[4], kp_[4]; float ss_ = 0.f, rk_ = 0.f; \
            _Pragma("unroll") for (int j = 0; j < 4; ++j) { r_[j] = zr_[j] + (pr_[j] - zr_[j]) * mu_r[j]; kr_[j] = zk_[j] + (pk_[j] - zk_[j]) * mu_k[j]; v_[j] = zv_[j] + (pv_[j] - zv_[j]) * mu_v[j]; \
                kk_[j] = kr_[j] * kkw[j]; ss_ += kk_[j] * kk_[j]; kp_[j] = kr_[j] * (1.0f + (a_[j] - 1.0f) * kaw[j]); rk_ += r_[j] * kp_[j] * rkw[j]; } \
            ss_ = sum16(ss_); rk_ = sum16(rk_); const float rn_ = 1.0f / sqrtf(ss_ + 1e-12f); \
            _Pragma("unroll") for (int j = 0; j < 4; ++j) kk_[j] *= rn_; \
            *(LAS f32x4*)(B_ + (0 * TC + ps) * 64 + k0) = (f32x4){-kk_[0], -kk_[1], -kk_[2], -kk_[3]}; \
            *(LAS f32x4*)(B_ + (1 * TC + ps) * 64 + k0) = (f32x4){__expf(-0.6065306597f * sigm(R.dec.x + w0w[0])), __expf(-0.6065306597f * sigm(R.dec.y + w0w[1])), __expf(-0.6065306597f * sigm(R.dec.z + w0w[2])), __expf(-0.6065306597f * sigm(R.dec.w + w0w[3]))}; \
            *(LAS f32x4*)(B_ + (2 * TC + ps) * 64 + k0) = (f32x4){kk_[0] * a_[0], kk_[1] * a_[1], kk_[2] * a_[2], kk_[3] * a_[3]}; \
            *(LAS f32x4*)(B_ + (3 * TC + ps) * 64 + k0) = (f32x4){kp_[0], kp_[1], kp_[2], kp_[3]}; \
            *(LAS f32x4*)(B_ + (4 * TC + ps) * 64 + k0) = (f32x4){r_[0], r_[1], r_[2], r_[3]}; \
            if ((kq >> 3) == half) *(LAS f32x4*)(B_ + VEC_F + ps * 32 + (k0 - half * 32)) = (f32x4){v_[0], v_[1], v_[2], v_[3]}; \
            if (kq == 0 && half == 0) RK[(size_t)m_ * NH + h] = rk_; } while (0)
        SCAN_LOAD(0); SCAN_FINISH(0, 0);
        __syncthreads();
        float S0 = S[0], S1 = S[1], S2 = S[2], S3 = S[3];
        LAS float* PB = (LAS float*)lds + 2 * BUF_F + wave * 1024;
        for (int c = 0; c < nch; ++c) {
            const int buf = c & 1;
            if (c + 1 < nch) SCAN_LOAD(c + 1);
            const LAS float* B = B0 + buf * BUF_F;
#define SCAN_LDV(nk_, w_, ka_, kp_, r_, vv_, s_) do { nk_ = *(const LAS f32x4*)(B + (0 * TC + (s_)) * 64 + k0); w_ = *(const LAS f32x4*)(B + (1 * TC + (s_)) * 64 + k0); ka_ = *(const LAS f32x4*)(B + (2 * TC + (s_)) * 64 + k0); \
                kp_ = *(const LAS f32x4*)(B + (3 * TC + (s_)) * 64 + k0); r_ = *(const LAS f32x4*)(B + (4 * TC + (s_)) * 64 + k0); vv_ = B[VEC_F + (s_) * 32 + ps]; } while (0)
            f32x4 nk, w, ka, kp, r; float vv;
            SCAN_LDV(nk, w, ka, kp, r, vv, 0);
#pragma unroll
            for (int s = 0; s < TC; ++s) {
                f32x4 nk2, w2, ka2, kp2, r2; float vv2;
                if (s + 1 < TC) SCAN_LDV(nk2, w2, ka2, kp2, r2, vv2, s + 1);
                float sa = mul_s(S0, nk.x); sa = fma_s(S1, nk.y, sa); sa = fma_s(S2, nk.z, sa); sa = fma_s(S3, nk.w, sa);
                sa = sum16(sa);
                S0 = fma_s(vv, kp.x, fma_s(sa, ka.x, mul_s(S0, w.x))); S1 = fma_s(vv, kp.y, fma_s(sa, ka.y, mul_s(S1, w.y)));
                S2 = fma_s(vv, kp.z, fma_s(sa, ka.z, mul_s(S2, w.z))); S3 = fma_s(vv, kp.w, fma_s(sa, ka.w, mul_s(S3, w.w)));
                float yp = mul_s(S0, r.x); yp = fma_s(S1, r.y, yp); yp = fma_s(S2, r.z, yp); yp = fma_s(S3, r.w, yp);
                PB[(s & 15) * 64 + lane] = yp;
                if ((s & 15) == 15) {
                    const f32x4 q0 = *(const LAS f32x4*)(PB + lane * 16), q1 = *(const LAS f32x4*)(PB + lane * 16 + 4), q2 = *(const LAS f32x4*)(PB + lane * 16 + 8), q3 = *(const LAS f32x4*)(PB + lane * 16 + 12);
                    const f32x4 qs = (q0 + q1) + (q2 + q3);
                    Y[(size_t)(m0 + c * TC + (s - 15) + (lane >> 2)) * 512 + h * 64 + half * 32 + 4 * wave + (lane & 3)] = (qs.x + qs.y) + (qs.z + qs.w);
                }
                if (s + 1 < TC) { nk = nk2; w = w2; ka = ka2; kp = kp2; r = r2; vv = vv2; }
            }
#undef SCAN_LDV
            if (c + 1 < nch) SCAN_FINISH(c + 1, buf ^ 1);
            __syncthreads();
        }
        S[0] = S0; S[1] = S1; S[2] = S2; S[3] = S3;
        *(f32x4*)sout = (f32x4){S[0], S[1], S[2], S[3]};
        __syncthreads();
#undef SCAN_LOAD
#undef SCAN_FINISH
    }
}

__device__ __forceinline__ void phase_post(LAS unsigned char* lds, int l) {
    const Params p = load_params(lds); int tid_ = threadIdx.x; asm volatile("" : "+v"(tid_)); const int tid = tid_, lane = tid & 63, wave = __builtin_amdgcn_readfirstlane(tid >> 6);
    const bf16* U = (const bf16*)(p.ws + WS_U); const bf16* AG = (const bf16*)(p.ws + WS_AG); const float* Y = (const float*)(p.ws + WS_TMP); const float* RK = (const float*)(p.ws + WS_RK);
    bf16* MIX = (bf16*)(p.ws + WS_H);
    const int gw = blockIdx.x * NWAVES + wave, NGW = gridDim.x * NWAVES, ch = 8 * lane, h = lane >> 3;
    float lg[8], lb[8], mu[8];
#pragma unroll
    for (int i = 0; i < 8; ++i) { lg[i] = p.lnx_g[l * DRW + ch + i]; lb[i] = p.lnx_b[l * DRW + ch + i]; mu[i] = p.mu_shift[(size_t)l * DSH + 1024 + ch + i]; }
    constexpr int NR = 2;
    f32x4 ny0[NR], ny1[NR]; v4u nuz[NR], nug[NR];
#define POST_PF(mb_) do { _Pragma("unroll") for (int r = 0; r < NR; ++r) { int m_ = (mb_) + r * NGW; if (m_ >= NTOK) m_ = gw; \
            ny0[r] = __builtin_nontemporal_load((const f32x4*)(Y + (size_t)m_ * 512 + ch)); ny1[r] = __builtin_nontemporal_load((const f32x4*)(Y + (size_t)m_ * 512 + ch + 4)); \
            nuz[r] = *(const v4u*)(U + (size_t)m_ * DIN + 1024 + 1024 + ch); nug[r] = __builtin_nontemporal_load((const v4u*)(AG + (size_t)m_ * 1024 + 512 + ch)); } } while (0)
    POST_PF(gw);
    for (int mb = gw; mb < NTOK; mb += NR * NGW) {
        int mm[NR]; bool ok[NR]; f32x4 y0[NR], y1[NR]; v4u uz[NR], ug[NR]; float zp[NR][8], rk[NR];
#pragma unroll
        for (int r = 0; r < NR; ++r) { const int m = mb + r * NGW; ok[r] = m < NTOK; mm[r] = ok[r] ? m : mb; const Tok k = tokinfo(mm[r]);
            y0[r] = ny0[r]; y1[r] = ny1[r]; uz[r] = nuz[r]; ug[r] = nug[r];
            zprev8(p, l, U, mm[r], k, 1024 + ch, zp[r]); rk[r] = RK[(size_t)mm[r] * NH + h]; }
        if (mb + NR * NGW < NTOK) POST_PF(mb + NR * NGW);
#pragma unroll
        for (int r = 0; r < NR; ++r) {
            float y[8] = {y0[r].x, y0[r].y, y0[r].z, y0[r].w, y1[r].x, y1[r].y, y1[r].z, y1[r].w};
            float zv[8], g[8]; unpack8(uz[r], zv); unpack8(ug[r], g);
            float s = 0.f;
#pragma unroll
            for (int i = 0; i < 8; ++i) s += y[i];
            const float mean = sum8(s) * (1.0f / 64.0f); float q2 = 0.f;
#pragma unroll
            for (int i = 0; i < 8; ++i) { y[i] -= mean; q2 += y[i] * y[i]; }
            const float rstd = 1.0f / sqrtf(sum8(q2) * (1.0f / 64.0f) + 64e-5f);
            float o[8];
#pragma unroll
            for (int i = 0; i < 8; ++i) { const float v = zv[i] + (zp[r][i] - zv[i]) * mu[i]; o[i] = ((y[i] * rstd * lg[i] + lb[i]) + rk[r] * v) * g[i]; }
            if (ok[r]) *(v4u*)(MIX + (size_t)mm[r] * DM + 512 + ch) = pack8(o);
        }
    }
}

constexpr int SC_SLOT = 14976, SC_GAB = 12928, SC_GAK = 13952, SC_AT = 0, SC_RT = 2048, SC_BK = 4096, SC_VT = 8448, SC_TT = 10624, SC_GG = 11648, SC_PC = 12672;
__device__ __forceinline__ int bk_off(int kap, int gg) { return (kap >> 2) * 272 + (kap & 3) * 64 + gg * 16; }
__device__ __forceinline__ int vt_off(int v, int gg) { return (v >> 2) * 136 + (v & 3) * 32 + gg * 8; }
constexpr int SC_SCR = 8 * SC_SLOT, SC_SCRSZ = 6144, SC_BT = 0, SC_KT = 2048, SC_CST = 4096;
static_assert(SC_SCR + 4 * SC_SCRSZ <= LDS_BYTES - 512, "scan LDS map");
typedef short s16x8 __attribute__((ext_vector_type(8)));
typedef __bf16 bf16x2_t __attribute__((ext_vector_type(2)));
__device__ __forceinline__ unsigned cvtpk(float lo, float hi) { f32x2 v = (f32x2){lo, hi}; bf16x2_t b2 = __builtin_convertvector(v, bf16x2_t); return __builtin_bit_cast(unsigned, b2); }
__device__ __forceinline__ s16x8 mk8(unsigned a, unsigned b, unsigned c, unsigned d) { v4u w = (v4u){a, b, c, d}; return __builtin_bit_cast(s16x8, w); }

#define SC_BAR() do { asm volatile("s_waitcnt lgkmcnt(0)" ::: "memory"); __builtin_amdgcn_s_barrier(); asm volatile("" ::: "memory"); } while (0)
__device__ __forceinline__ void phase_scan2(LAS unsigned char* lds, int l) {
    const Params p = load_params(lds); int tid_ = threadIdx.x; asm volatile("" : "+v"(tid_)); const int tid = tid_;
    const bf16* U = (const bf16*)(p.ws + WS_U); const float* DEC = (const float*)(p.ws + WS_DEC); const bf16* AG = (const bf16*)(p.ws + WS_AG);
    float* Y = (float*)(p.ws + WS_TMP); float* RK = (float*)(p.ws + WS_RK);
    const int lane = tid & 63, wave = __builtin_amdgcn_readfirstlane(tid >> 6);
    const int li = lane & 15, g = lane >> 4;
    for (int unit = blockIdx.x; unit < 192; unit += gridDim.x) {
        int smp, b, h, T, m0;
        if (unit < 128) { smp = 0; b = unit >> 3; h = unit & 7; T = TP; m0 = b * TP; }
        else { const int v = unit - 128; smp = 1; b = v >> 3; h = v & 7; T = TS; m0 = NP + b * TS; }
        const int nR = T / 64;
        if (wave >= 4) {
            const int pw = wave - 4, kq = li, tg = g, k0 = 4 * kq, hc = h * 64 + k0;
            LAS unsigned char* scr = lds + SC_SCR + pw * SC_SCRSZ;
            const int ks = k0 >> 5, khalf = (k0 & 31) >> 4, kg = (k0 & 15) >> 2;
#define SC_LOADS(cc) do { _Pragma("unroll") for (int q = 0; q < 4; ++q) { const int t_ = (cc) * 16 + 4 * tg + q, m_ = m0 + t_; const bf16* ur_ = U + (size_t)m_ * DIN + 1024 + hc; \
                    zr[q] = __builtin_nontemporal_load((const v2u*)ur_); zk[q] = __builtin_nontemporal_load((const v2u*)(ur_ + 512)); zv[q] = __builtin_nontemporal_load((const v2u*)(ur_ + 1024)); \
                    if (q == 0) { if (t_ > 0) { pr0 = *(const v2u*)(ur_ - DIN); pk0 = *(const v2u*)(ur_ - DIN + 512); pv0 = *(const v2u*)(ur_ - DIN + 1024); } \
                        else { pr0 = (v2u){0u, 0u}; pk0 = (v2u){0u, 0u}; pv0 = (v2u){0u, 0u}; } } \
                    dec[q] = __builtin_nontemporal_load((const f32x4*)(DEC + (size_t)m_ * 512 + hc)); av[q] = __builtin_nontemporal_load((const v2u*)(AG + (size_t)m_ * 1024 + hc)); } } while (0)
            v2u zr[4], zk[4], zv[4], pr0, pk0, pv0, av[4]; f32x4 dec[4];
            if (tg == 0) { LAS f32x4* ct = (LAS f32x4*)(scr + SC_CST + k0 * 4);
                ct[0] = *(const f32x4*)(p.mu_shift + (size_t)l * DSH + hc); ct[16] = *(const f32x4*)(p.mu_shift + (size_t)l * DSH + 512 + hc); ct[32] = *(const f32x4*)(p.mu_shift + (size_t)l * DSH + 1024 + hc);
                ct[48] = *(const f32x4*)(p.k_k + l * DRW + hc); ct[64] = *(const f32x4*)(p.k_a + l * DRW + hc); ct[80] = *(const f32x4*)(p.r_k + l * DRW + hc);
                ct[96] = *(const f32x4*)(p.w0 + l * DRW + hc); ct[112] = *(const f32x4*)(p.a0 + l * DRW + hc); }
            asm volatile("s_waitcnt lgkmcnt(0)" ::: "memory");
            SC_LOADS(pw);
            for (int R = -1; R + 1 < nR; ++R) {
                const int c = 4 * (R + 1) + pw;
                LAS unsigned char* slot = lds + (((R + 1) & 1) * 4 + pw) * SC_SLOT;
                float mu_r[4], mu_k[4], mu_v[4], kkw[4], kaw[4], rkw[4], w0w[4], a0w[4];
                { const LAS f32x4* ct = (const LAS f32x4*)(scr + SC_CST + k0 * 4);
                  const f32x4 c0 = ct[0], c1 = ct[16], c2 = ct[32], c3 = ct[48], c4 = ct[64], c5 = ct[80], c6 = ct[96], c7 = ct[112];
#pragma unroll
                  for (int j = 0; j < 4; ++j) { mu_r[j] = c0[j]; mu_k[j] = c1[j]; mu_v[j] = c2[j]; kkw[j] = c3[j]; kaw[j] = c4[j]; rkw[j] = c5[j]; w0w[j] = c6[j]; a0w[j] = c7[j]; } }
                float r_[4][4], kp_[4][4], v_[4][4], al_[4][4], be_[4][4], ce[4][4];
#pragma unroll
                for (int q = 0; q < 4; ++q) { const int t_ = c * 16 + 4 * tg + q, m_ = m0 + t_;
                    float zr_[4] = {bflo(zr[q].x), bfhi(zr[q].x), bflo(zr[q].y), bfhi(zr[q].y)}, zk_[4] = {bflo(zk[q].x), bfhi(zk[q].x), bflo(zk[q].y), bfhi(zk[q].y)}, zv_[4] = {bflo(zv[q].x), bfhi(zv[q].x), bflo(zv[q].y), bfhi(zv[q].y)};
                    const v2u prq = (q == 0) ? pr0 : zr[q > 0 ? q - 1 : 0], pkq = (q == 0) ? pk0 : zk[q > 0 ? q - 1 : 0], pvq = (q == 0) ? pv0 : zv[q > 0 ? q - 1 : 0];
                    float pr_[4] = {bflo(prq.x), bfhi(prq.x), bflo(prq.y), bfhi(prq.y)}, pk_[4] = {bflo(pkq.x), bfhi(pkq.x), bflo(pkq.y), bfhi(pkq.y)}, pv_[4] = {bflo(pvq.x), bfhi(pvq.x), bflo(pvq.y), bfhi(pvq.y)};
                    if (q == 0 && smp && t_ == 0) { const float* s_ = p.state_shift + (l * BS + b) * DSH + hc;
#pragma unroll
                        for (int j = 0; j < 4; ++j) { pr_[j] = s_[j]; pk_[j] = s_[512 + j]; pv_[j] = s_[1024 + j]; } }
                    const float a_[4] = {bflo(av[q].x), bfhi(av[q].x), bflo(av[q].y), bfhi(av[q].y)};
                    const float dq[4] = {dec[q].x, dec[q].y, dec[q].z, dec[q].w};
                    float kk_[4]; float ss_ = 0.f, rk_ = 0.f;
#pragma unroll
                    for (int j = 0; j < 4; ++j) { r_[q][j] = zr_[j] + (pr_[j] - zr_[j]) * mu_r[j]; const float kr = zk_[j] + (pk_[j] - zk_[j]) * mu_k[j]; v_[q][j] = zv_[j] + (pv_[j] - zv_[j]) * mu_v[j];
                        kk_[j] = kr * kkw[j]; ss_ += kk_[j] * kk_[j]; kp_[q][j] = kr * (1.0f + (a_[j] - 1.0f) * kaw[j]); rk_ += r_[q][j] * kp_[q][j] * rkw[j];
                        const float e = dq[j]; ce[q][j] = (q > 0 ? ce[q > 0 ? q - 1 : 0][j] : 0.f) + e; }
                    ss_ = sum16(ss_); rk_ = sum16(rk_); const float rn_ = __builtin_amdgcn_rsqf(ss_ + 1e-12f);
#pragma unroll
                    for (int j = 0; j < 4; ++j) { const float kn = kk_[j] * rn_; al_[q][j] = -kn; be_[q][j] = kn * a_[j]; }
                    if (kq == 0) RK[(size_t)m_ * NH + h] = rk_; }
                SC_BAR();
                float ex[4], l15[4];
#pragma unroll
                for (int j = 0; j < 4; ++j) { const float tot = ce[3][j]; const float t1 = shfl_lane(tot, (lane + 48) & 63), t2 = shfl_lane(tot, (lane + 32) & 63), t3 = shfl_lane(tot, (lane + 16) & 63);
                    ex[j] = (tg >= 1 ? t1 : 0.f) + (tg >= 2 ? t2 : 0.f) + (tg >= 3 ? t3 : 0.f);
                    const float all = shfl_lane(tot + ex[j], 48 + kq); l15[j] = -all; }
                unsigned bh[4][2], kh[4][2], vt[4][2];
                float Bh[4][4], Kh[4][4];
                float pin_[4][4], pc_[4], p0_[4];
#pragma unroll
                for (int j = 0; j < 4; ++j) { pc_[j] = __expf(l15[j]); p0_[j] = __expf(-ex[j]);
#pragma unroll
                    for (int q = 0; q < 4; ++q) pin_[q][j] = __expf(-(ex[j] + ce[q][j])); }
#pragma unroll
                for (int q = 0; q < 4; ++q) { const int i = 4 * tg + q; float At[4], Rt[4], Bt[4], Kt[4];
#pragma unroll
                    for (int j = 0; j < 4; ++j) { const float pin = pin_[q][j], ppr = (q > 0) ? pin_[q > 0 ? q - 1 : 0][j] : p0_[j], pinv = __builtin_amdgcn_rcpf(pin), phat = pc_[j] * pinv;
                        At[j] = al_[q][j] * ppr; Rt[j] = r_[q][j] * pin; Bt[j] = be_[q][j] * pinv; Kt[j] = kp_[q][j] * pinv; Bh[q][j] = be_[q][j] * phat; Kh[q][j] = kp_[q][j] * phat; }
                    const int off = (((i * 2 + ks) * 4 + kg) * 8 + khalf * 4) * 2;
                    *(LAS v2u*)(slot + SC_AT + off) = (v2u){cvtpk(At[0], At[1]), cvtpk(At[2], At[3])};
                    *(LAS v2u*)(slot + SC_RT + off) = (v2u){cvtpk(Rt[0], Rt[1]), cvtpk(Rt[2], Rt[3])};
                    *(LAS v2u*)(scr + SC_BT + off) = (v2u){cvtpk(Bt[0], Bt[1]), cvtpk(Bt[2], Bt[3])};
                    *(LAS v2u*)(scr + SC_KT + off) = (v2u){cvtpk(Kt[0], Kt[1]), cvtpk(Kt[2], Kt[3])}; }
#pragma unroll
                for (int jj = 0; jj < 4; ++jj) { const int kap = k0 + jj;
                    *(LAS v2u*)(slot + SC_BK + bk_off(kap, tg)) = (v2u){cvtpk(Bh[0][jj], Bh[1][jj]), cvtpk(Bh[2][jj], Bh[3][jj])};
                    *(LAS v2u*)(slot + SC_BK + bk_off(kap, tg) + 8) = (v2u){cvtpk(Kh[0][jj], Kh[1][jj]), cvtpk(Kh[2][jj], Kh[3][jj])};
                    *(LAS v2u*)(slot + SC_VT + vt_off(kap, tg)) = (v2u){cvtpk(v_[0][jj], v_[1][jj]), cvtpk(v_[2][jj], v_[3][jj])}; }
                if (tg == 0) *(LAS f32x4*)(slot + SC_PC + k0 * 4) = (f32x4){pc_[0], pc_[1], pc_[2], pc_[3]};
                asm volatile("s_waitcnt lgkmcnt(0)" ::: "memory");
                if (R + 2 < nR) SC_LOADS(c + 4);
                {
                    const int o0 = ((li * 2 + 0) * 4 + g) * 16, o1 = ((li * 2 + 1) * 4 + g) * 16;
                    const s16x8 aA0 = *(const LAS s16x8*)(slot + SC_AT + o0), aA1 = *(const LAS s16x8*)(slot + SC_AT + o1), aR0 = *(const LAS s16x8*)(slot + SC_RT + o0), aR1 = *(const LAS s16x8*)(slot + SC_RT + o1);
                    const s16x8 bB0 = *(const LAS s16x8*)(scr + SC_BT + o0), bB1 = *(const LAS s16x8*)(scr + SC_BT + o1), bK0 = *(const LAS s16x8*)(scr + SC_KT + o0), bK1 = *(const LAS s16x8*)(scr + SC_KT + o1);
                    const f32x4 z4 = (f32x4){0.f, 0.f, 0.f, 0.f};
                    f32x4 Gab = __builtin_amdgcn_mfma_f32_16x16x32_bf16(aA0, bB0, z4, 0, 0, 0); Gab = __builtin_amdgcn_mfma_f32_16x16x32_bf16(aA1, bB1, Gab, 0, 0, 0);
                    f32x4 Gak = __builtin_amdgcn_mfma_f32_16x16x32_bf16(aA0, bK0, z4, 0, 0, 0); Gak = __builtin_amdgcn_mfma_f32_16x16x32_bf16(aA1, bK1, Gak, 0, 0, 0);
                    f32x4 Grb = __builtin_amdgcn_mfma_f32_16x16x32_bf16(aR0, bB0, z4, 0, 0, 0); Grb = __builtin_amdgcn_mfma_f32_16x16x32_bf16(aR1, bB1, Grb, 0, 0, 0);
                    f32x4 Grk = __builtin_amdgcn_mfma_f32_16x16x32_bf16(aR0, bK0, z4, 0, 0, 0); Grk = __builtin_amdgcn_mfma_f32_16x16x32_bf16(aR1, bK1, Grk, 0, 0, 0);
#pragma unroll
                    for (int r = 0; r < 4; ++r) { const int i = 4 * g + r; const bool lo = li < i, le = li <= i;
                        *(LAS float*)(slot + SC_GAB + (i * 16 + li) * 4) = lo ? Gab[r] : 0.f; *(LAS float*)(slot + SC_GAK + (i * 16 + li) * 4) = lo ? Gak[r] : 0.f;
                        *(LAS bf16*)(slot + SC_GG + ((i * 4 + (li >> 2)) * 8 + (li & 3)) * 2) = (bf16)cvtpk(le ? Grb[r] : 0.f, 0.f);
                        *(LAS bf16*)(slot + SC_GG + ((i * 4 + (li >> 2)) * 8 + 4 + (li & 3)) * 2) = (bf16)cvtpk(le ? Grk[r] : 0.f, 0.f); }
                }
                SC_BAR();
            }
            SC_BAR(); SC_BAR();
        } else {
            const int v0 = 16 * wave;
            f32x4 St[4];
            const int sbase = ((smp ? l * BS + b : l * BP + b) * NH + h) * 4096 + (v0 + li) * 64 + 4 * g;
            if (smp) {
#pragma unroll
                for (int t = 0; t < 4; ++t) St[t] = *(const f32x4*)(p.state_wkv + sbase + 16 * t); }
            else {
#pragma unroll
                for (int t = 0; t < 4; ++t) St[t] = (f32x4){0.f, 0.f, 0.f, 0.f}; }
            SC_BAR(); SC_BAR();
            for (int R = 0; R < nR; ++R) {
                { LAS unsigned char* tsl = lds + ((R & 1) * 4 + wave) * SC_SLOT;
                {
                    float Z[16]; int lic = li; asm volatile("" : "+v"(lic));
                    const LAS f32x4* gabp = (const LAS f32x4*)(tsl + SC_GAB);
                    f32x4 n0 = gabp[4], n1 = gabp[5], n2 = gabp[6], n3 = gabp[7]; float nrhs = (g & 1) ? *(const LAS float*)(tsl + SC_GAK + (16 + lic) * 4) : (1 == lic ? 1.0f : 0.f);
                    Z[0] = (g & 1) ? *(const LAS float*)(tsl + SC_GAK + lic * 4) : (0 == lic ? 1.0f : 0.f);
                    *(LAS bf16*)(tsl + SC_TT + ((0 * 4 + (li >> 2)) * 8 + (g & 1) * 4 + (li & 3)) * 2) = (bf16)cvtpk(Z[0], 0.f);
#pragma unroll
                    for (int i = 1; i < 16; ++i) {
                        const f32x4 g0 = n0, g1 = n1, g2 = n2, g3 = n3; const float rhs = nrhs;
                        if (i + 1 < 16) { n0 = gabp[(i + 1) * 4]; n1 = gabp[(i + 1) * 4 + 1]; n2 = gabp[(i + 1) * 4 + 2]; n3 = gabp[(i + 1) * 4 + 3];
                            nrhs = (g & 1) ? *(const LAS float*)(tsl + SC_GAK + ((i + 1) * 16 + lic) * 4) : ((i + 1) == lic ? 1.0f : 0.f); }
                        const float gr[16] = {g0.x, g0.y, g0.z, g0.w, g1.x, g1.y, g1.z, g1.w, g2.x, g2.y, g2.z, g2.w, g3.x, g3.y, g3.z, g3.w};
                        float acc0 = rhs, acc1 = 0.f;
#pragma unroll
                        for (int j = 0; j < 16; ++j) if (j < i) { if (j & 1) acc1 += gr[j] * Z[j]; else acc0 += gr[j] * Z[j]; }
                        const float acc = acc0 + acc1;
                        Z[i] = acc;
                        *(LAS bf16*)(tsl + SC_TT + ((i * 4 + (li >> 2)) * 8 + (g & 1) * 4 + (li & 3)) * 2) = (bf16)cvtpk(acc, 0.f);
                    }
                }
                }
                SC_BAR();
#pragma unroll 1
                for (int q = 0; q < 4; ++q) {
                    const LAS unsigned char* slot = lds + ((R & 1) * 4 + q) * SC_SLOT; const int c = 4 * R + q;
                    const int o0 = ((li * 2 + 0) * 4 + g) * 16, o1 = ((li * 2 + 1) * 4 + g) * 16;
                    const s16x8 aA0 = *(const LAS s16x8*)(slot + SC_AT + o0), aA1 = *(const LAS s16x8*)(slot + SC_AT + o1), aR0 = *(const LAS s16x8*)(slot + SC_RT + o0), aR1 = *(const LAS s16x8*)(slot + SC_RT + o1);
                    const s16x8 aT = *(const LAS s16x8*)(slot + SC_TT + (li * 4 + g) * 16), aG = *(const LAS s16x8*)(slot + SC_GG + (li * 4 + g) * 16);
                    const v2u vq = *(const LAS v2u*)(slot + SC_VT + vt_off(v0 + li, g));
                    const s16x8 bS0 = mk8(cvtpk(St[0][0], St[0][1]), cvtpk(St[0][2], St[0][3]), cvtpk(St[1][0], St[1][1]), cvtpk(St[1][2], St[1][3]));
                    const s16x8 bS1 = mk8(cvtpk(St[2][0], St[2][1]), cvtpk(St[2][2], St[2][3]), cvtpk(St[3][0], St[3][1]), cvtpk(St[3][2], St[3][3]));
                    const f32x4 z4 = (f32x4){0.f, 0.f, 0.f, 0.f};
                    f32x4 Xa = __builtin_amdgcn_mfma_f32_16x16x32_bf16(aA0, bS0, z4, 0, 0, 0); Xa = __builtin_amdgcn_mfma_f32_16x16x32_bf16(aA1, bS1, Xa, 0, 0, 0);
                    f32x4 Xr = __builtin_amdgcn_mfma_f32_16x16x32_bf16(aR0, bS0, z4, 0, 0, 0); Xr = __builtin_amdgcn_mfma_f32_16x16x32_bf16(aR1, bS1, Xr, 0, 0, 0);
                    const s16x8 bXV = mk8(cvtpk(Xa[0], Xa[1]), cvtpk(Xa[2], Xa[3]), vq.x, vq.y);
                    const f32x4 Uu = __builtin_amdgcn_mfma_f32_16x16x32_bf16(aT, bXV, z4, 0, 0, 0);
                    const s16x8 bUV = mk8(cvtpk(Uu[0], Uu[1]), cvtpk(Uu[2], Uu[3]), vq.x, vq.y);
                    const f32x4 Yy = __builtin_amdgcn_mfma_f32_16x16x32_bf16(aG, bUV, Xr, 0, 0, 0);
#pragma unroll
                    for (int t = 0; t < 4; ++t) { const s16x8 aBK = *(const LAS s16x8*)(slot + SC_BK + bk_off(16 * t + li, g)); const f32x4 pc = *(const LAS f32x4*)(slot + SC_PC + (16 * t + 4 * g) * 4);
                        St[t] = __builtin_amdgcn_mfma_f32_16x16x32_bf16(aBK, bUV, pc * St[t], 0, 0, 0); }
                    int liq = lane; asm volatile("" : "+v"(liq));
                    float* yo = Y + (size_t)(m0 + 16 * c + 4 * (liq >> 4)) * 512 + h * 64 + v0 + (liq & 15);
                    yo[0] = Yy[0]; yo[512] = Yy[1]; yo[1024] = Yy[2]; yo[1536] = Yy[3];
                }
                SC_BAR();
            }
            float* so = p.out + (smp ? O_WKVS : O_WKVP) + sbase;
#pragma unroll
            for (int t = 0; t < 4; ++t) *(f32x4*)(so + 16 * t) = St[t];
        }
    }
}

__device__ __forceinline__ void small_tile(LAS unsigned char* lds, const bf16* A, const bf16* Bt, int K, int arow0, int brow0, float* res) {
    int tid_ = threadIdx.x; asm volatile("" : "+v"(tid_)); const int tid = tid_, lane = tid & 63, wave = __builtin_amdgcn_readfirstlane(tid >> 6), fr = lane & 15, fq = lane >> 4;
    const int ksl = K >> 3, kbeg = wave * ksl;
    pg8::f32x4 acc[4][4];
#pragma unroll
    for (int i = 0; i < 4; ++i)
#pragma unroll
        for (int j = 0; j < 4; ++j) acc[i][j] = (pg8::f32x4){0.f, 0.f, 0.f, 0.f};
    const bf16* ap = A + (size_t)(arow0 + fr) * K + kbeg + 8 * fq; const bf16* bp = Bt + (size_t)(brow0 + fr) * K + kbeg + 8 * fq;
    pg8::bf16x8 af[4], bfr[4], af2[4], bf2[4];
#pragma unroll
    for (int i = 0; i < 4; ++i) { af[i] = *(const pg8::bf16x8*)(ap + (size_t)(16 * i) * K); bfr[i] = *(const pg8::bf16x8*)(bp + (size_t)(16 * i) * K); }
    for (int k = 0; k < ksl; k += 64) {
        const int k1 = k + 32, k2 = (k + 64 < ksl) ? k + 64 : k;
        const int k1c = (k1 < ksl) ? k1 : k;
#pragma unroll
        for (int i = 0; i < 4; ++i) { af2[i] = *(const pg8::bf16x8*)(ap + (size_t)(16 * i) * K + k1c); bf2[i] = *(const pg8::bf16x8*)(bp + (size_t)(16 * i) * K + k1c); }
#pragma unroll
        for (int i = 0; i < 4; ++i)
#pragma unroll
            for (int j = 0; j < 4; ++j) acc[i][j] = __builtin_amdgcn_mfma_f32_16x16x32_bf16(bfr[j], af[i], acc[i][j], 0, 0, 0);
#pragma unroll
        for (int i = 0; i < 4; ++i) { af[i] = *(const pg8::bf16x8*)(ap + (size_t)(16 * i) * K + k2); bfr[i] = *(const pg8::bf16x8*)(bp + (size_t)(16 * i) * K + k2); }
        if (k1 < ksl) {
#pragma unroll
            for (int i = 0; i < 4; ++i)
#pragma unroll
                for (int j = 0; j < 4; ++j) acc[i][j] = __builtin_amdgcn_mfma_f32_16x16x32_bf16(bf2[j], af2[i], acc[i][j], 0, 0, 0);
        }
    }
    LAS float* part = (LAS float*)lds;
#pragma unroll
    for (int i = 0; i < 4; ++i)
#pragma unroll
        for (int j = 0; j < 4; ++j) *(LAS pg8::f32x4*)(part + ((wave * 64 + 16 * i + fr) * 64 + 16 * j + 4 * fq)) = acc[i][j];
    __syncthreads();
    const int m = tid >> 3, n0 = (tid & 7) * 8;
    pg8::f32x4 s0 = (pg8::f32x4){0.f, 0.f, 0.f, 0.f}, s1 = s0;
#pragma unroll
    for (int w = 0; w < 8; ++w) { s0 += *(const LAS pg8::f32x4*)(part + ((w * 64 + m) * 64 + n0)); s1 += *(const LAS pg8::f32x4*)(part + ((w * 64 + m) * 64 + n0 + 4)); }
    res[0] = s0[0]; res[1] = s0[1]; res[2] = s0[2]; res[3] = s0[3]; res[4] = s1[0]; res[5] = s1[1]; res[6] = s1[2]; res[7] = s1[3];
    __syncthreads();
}
__device__ __forceinline__ void small_gemm(LAS unsigned char* lds, const bf16* A, const bf16* Bt, int K, int N, int mode, bf16* O, int ldc, float* F, const float* bw, const float* ba, unsigned* ctr) {
    int tid_ = threadIdx.x; asm volatile("" : "+v"(tid_)); const int tid = tid_;
    const int ntn = N / 64, ntiles = (NS / 64) * ntn, m = tid >> 3, n0 = (tid & 7) * 8;
    volatile LAS unsigned* tq = (volatile LAS unsigned*)(lds + PTAB_OFF + 416);
    for (;;) {
        if (tid == 0) tq[0] = __hip_atomic_fetch_add(ctr, 1u, __ATOMIC_RELAXED, __HIP_MEMORY_SCOPE_AGENT);
        __syncthreads();
        const int t = (int)tq[0];
        __syncthreads();
        if (t >= ntiles) break;
        const int tm = t / ntn, tn = t % ntn, row = NP + 64 * tm + m, c0 = 64 * tn;
        float r[8];
        if (mode == 1) {
            float g[8]; const int br = (c0 >> 7) * 256 + (c0 & 127);
            small_tile(lds, A, Bt, K, NP + 64 * tm, br, g);
            small_tile(lds, A, Bt, K, NP + 64 * tm, br + 128, r);
#pragma unroll
            for (int i = 0; i < 8; ++i) r[i] = g[i] * sigm(g[i]) * r[i];
            *(v4u*)(O + (size_t)row * ldc + c0 + n0) = pack8(r);
        } else {
            small_tile(lds, A, Bt, K, NP + 64 * tm, c0, r);
            if (mode == 2 && c0 < 512) {
#pragma unroll
                for (int i = 0; i < 8; ++i) r[i] = 0.6065306597f * sigm(r[i] + bw[c0 + n0 + i]);
                float* o = F + (size_t)row * 512 + c0 + n0; *(f32x4*)o = (f32x4){r[0], r[1], r[2], r[3]}; *(f32x4*)(o + 4) = (f32x4){r[4], r[5], r[6], r[7]}; }
            else { if (mode == 2 && c0 < 1024) {
#pragma unroll
                    for (int i = 0; i < 8; ++i) r[i] = sigm(r[i] + ba[c0 - 512 + n0 + i]); }
                *(v4u*)(O + (size_t)row * ldc + (mode == 2 ? c0 - 512 : c0) + n0) = pack8(r); }
        }
    }
}


constexpr size_t WS_BAR = 4 * MiB + 512 * 1024;
static_assert(WS_RK + (size_t)NTOK * NH * 4 <= WS_BAR && XCD_BAR_WORDS * 4 <= 16384 && WS_BAR + 16384 + 1024 <= WS_WIN, "barrier words + the ten sample-tile counters (one 64-B line per GEMM phase)");
__device__ __forceinline__ void grid_bar(LAS unsigned char* lds) {
    int i34 = 34; asm volatile("" : "+s"(i34));
    XcdBarrier b; b.bar = (unsigned*)((__attribute__((address_space(1))) unsigned char*)ldp_(lds, i34) + WS_BAR); b.x = xb_xcc_id(); b.st = (volatile LAS unsigned*)(lds + PTAB_OFF + 400);
    xcd_barrier(b);
}
#define GSYNC() grid_bar(lds)
#define CONV_CTR(l_) ((unsigned*)((__attribute__((address_space(1))) unsigned char*)ldp_(lds, 34) + WS_BAR + 16384) + (10 + (l_)) * 16)
__global__ void __launch_bounds__(NTHR, 2) hymba_fwd(Params p) {
    extern __shared__ __attribute__((aligned(16))) unsigned char lds_raw[];
    cg::grid_group grid = cg::this_grid();
    LAS unsigned char* lds = (LAS unsigned char*)lds_raw;
    if (threadIdx.x == 0) { store_params(p, lds); ((volatile LAS unsigned*)(lds + PTAB_OFF + 400))[0] = 0u; ((volatile LAS unsigned*)(lds + PTAB_OFF + 400))[1] = 0u; }
    __syncthreads();
    (void)xcd_barrier_post((unsigned*)(p.ws + WS_BAR), (volatile LAS unsigned*)(lds + PTAB_OFF + 400));
    if ((int)gridDim.x >= 192) {
        if ((int)blockIdx.x < (int)gridDim.x - 96) phase_weights(lds, 0, 0, (int)gridDim.x - 96); else phase_mod(lds, (int)gridDim.x - 96);
    } else { phase_weights(lds, 0, 0, (int)gridDim.x); __syncthreads(); phase_mod(lds, 0); }
    grid.sync();
    phase_rows<0>(lds, 0);
    GSYNC();
    for (int st = 0; st < 10; ++st) {
        const int l = st / 5, k = st % 5;
        {
            pg8::Gemm g; pg8::EpiMulti E; int N;
            int i34 = 34; asm volatile("" : "+s"(i34));
            unsigned char* ws = (unsigned char*)(__attribute__((address_space(1))) unsigned char*)ldp_(lds, i34);
            bf16* Ub = (bf16*)(ws + WS_U); bf16* Hb = (bf16*)(ws + WS_H); bf16* TMPb = (bf16*)(ws + WS_TMP);
            if (k == 0)      { N = DIN;     g.A = Hb; g.Bt = (const bf16*)(ws + WS_WIN) + (size_t)l * DIN * DM; g.K = DM; E.mode = 0; E.O = Ub; E.ldc = DIN; E.F = nullptr; E.bw = nullptr; E.ba = nullptr; }
            else if (k == 1) { N = 1536;    g.A = (const bf16*)(ws + WS_LA); g.Bt = (const bf16*)(ws + WS_WLR) + (size_t)l * 1536 * 256; g.K = 256; E.mode = 2; E.O = (bf16*)(ws + WS_AG); E.ldc = 1024; E.F = (float*)(ws + WS_DEC); E.bw = (const float*)(__attribute__((address_space(1))) const float*)ldp_(lds, 19) + l * DRW; E.ba = (const float*)(__attribute__((address_space(1))) const float*)ldp_(lds, 21) + l * DRW; }
            else if (k == 2) { N = DM;      g.A = Hb; g.Bt = (const bf16*)(ws + WS_WOUT) + (size_t)l * DM * DM; g.K = DM; E.mode = 0; E.O = TMPb; E.ldc = DM; E.F = nullptr; E.bw = nullptr; E.ba = nullptr; }
            else if (k == 3) { N = 2 * DFF; g.A = Hb; g.Bt = (const bf16*)(ws + WS_WGU) + (size_t)l * 2 * DFF * DM; g.K = DM; E.mode = 1; E.O = Ub; E.ldc = DFF; E.F = nullptr; E.bw = nullptr; E.ba = nullptr; }
            else             { N = DM;      g.A = Ub; g.Bt = (const bf16*)(ws + WS_WDN) + (size_t)l * DM * DFF; g.K = DFF; E.mode = 0; E.O = TMPb; E.ldc = DM; E.F = nullptr; E.bw = nullptr; E.ba = nullptr; }
            g.M = NP; g.N = N;
            pg8::StaticOrder S; S.init(NP, N, (int)gridDim.x, (int)blockIdx.x);
            pg8::gemm_phase<pg8::EpiMulti, pg8::StaticOrder, true, true>(lds, g, S, E);
            small_gemm(lds, g.A, g.Bt, g.K, k == 3 ? DFF : N, E.mode, E.O, E.ldc, E.F, E.bw, E.ba, (unsigned*)(ws + WS_BAR + 16384) + st * 16);
        }
        GSYNC();
        if (k == 0) { phase_prepA(lds, l); GSYNC(); }
        else if (k == 1) { phase_scan2(lds, l); if ((int)gridDim.x >= 256) { if (blockIdx.x >= 128) { __syncthreads(); phase_conv(lds, l, CONV_CTR(l)); if (l == 0) { __syncthreads(); phase_weights(lds, 1, 128, (int)gridDim.x - 128); } } } else { __syncthreads(); phase_conv(lds, l, CONV_CTR(l)); if (l == 0) { __syncthreads(); phase_weights(lds, 1, 0, (int)gridDim.x); } } GSYNC(); phase_post(lds, l); GSYNC(); }
        else if (k == 2) { phase_rows<1>(lds, l); GSYNC(); }
        else if (k == 4) { phase_rows<2>(lds, l); if (l == 0) GSYNC(); }
    }
}

extern "C" void kernel_launch(void* const* d_in, const int* in_sizes, int n_in, void* d_out, int out_size, void* d_ws, size_t ws_size, hipStream_t stream) {
    static int grid = 0;
    if (grid == 0) {
        if (n_in != 33 || ws_size < WS_END) { fprintf(stderr, "kernel_launch: unexpected n_in %d / ws_size %zu (need %zu)\n", n_in, ws_size, (size_t)WS_END); grid = -1; return; }
        int dev = 0, cus = 0, per_cu = 0;
        (void)hipGetDevice(&dev); (void)hipDeviceGetAttribute(&cus, hipDeviceAttributeMultiprocessorCount, dev);
        if (hipFuncSetAttribute((const void*)hymba_fwd, hipFuncAttributeMaxDynamicSharedMemorySize, LDS_BYTES) != hipSuccess) { fprintf(stderr, "kernel_launch: hipFuncSetAttribute failed\n"); grid = -1; return; }
        if (hipOccupancyMaxActiveBlocksPerMultiprocessor(&per_cu, (const void*)hymba_fwd, NTHR, LDS_BYTES) != hipSuccess || per_cu < 1) { fprintf(stderr, "kernel_launch: occupancy query gave %d\n", per_cu); per_cu = 1; }
        (void)hipGetLastError();
        grid = cus * per_cu;
        fprintf(stderr, "kernel_launch: grid %d (cus %d x %d)\n", grid, cus, per_cu);
    }
    if (grid < 0) return;
    (void)hipMemsetAsync((char*)d_ws + WS_BAR, 0, 16384 + 1024, stream);
    Params p{};
    const float** pp = (const float**)&p;
    for (int i = 0; i < 33; ++i) pp[i] = (const float*)d_in[i];
    p.out = (float*)d_out; p.ws = (unsigned char*)d_ws;
    void* args[] = {&p};
    hipError_t e = hipLaunchCooperativeKernel((const void*)hymba_fwd, dim3(grid), dim3(NTHR), args, LDS_BYTES, stream);
    if (e != hipSuccess) fprintf(stderr, "kernel_launch: cooperative launch failed: %s (grid %d)\n", hipGetErrorString(e), grid);
}
```
